# Optimizing an MI355X kernel written in HIP

```python
import math
import jax, jax.numpy as jnp
from jax import lax
import numpy as np

D_MODEL = 1024
BATCH = 2
SEQ = 8192
DEPTH = 1
DEC_BATCH = 128
DEC_SEQ = 4
PAST_LEN = 2048
PAGE_SIZE = 128

MIX_W = D_MODEL
MLSTM_W = MIX_W // 2
MLSTM_HEADS = 4
MLSTM_DH = MLSTM_W // MLSTM_HEADS
ATTN_W = MIX_W - MLSTM_W
ATTN_HEADS = 8
ATTN_DH = ATTN_W // ATTN_HEADS
DILATED = ((128, 1), (512, 4), (2048, 16))
WINDOW_MAX = 2048
BLK = 128
CONV_W = 4
CHUNK = 64
MEM_LEN = 256
MEM_HEADS = 4
MEM_DH = D_MODEL // MEM_HEADS
D_FF = -(-8 * D_MODEL // (3 * 256)) * 256
EPS = 1e-6
_WIDTHS = (MLSTM_W, MLSTM_W, MLSTM_W, MLSTM_W, MLSTM_HEADS, MLSTM_HEADS, ATTN_W, ATTN_W, ATTN_W)
SPLIT_POINTS = tuple(int(s) for s in np.cumsum(_WIDTHS)[:-1])
N_IN = int(sum(_WIDTHS))

kernel_name = 'hymba_mlstm_dilated_swa_memxattn_step'


def rmsnorm(x, g):
    xf = x.astype(jnp.float32)
    y = xf * lax.rsqrt(jnp.mean(xf * xf, axis=-1, keepdims=True) + EPS)
    return (y * g.astype(jnp.float32)).astype(x.dtype)


def headwise_layernorm(h, g):
    mu = jnp.mean(h, axis=-1, keepdims=True)
    var = jnp.mean(jnp.square(h - mu), axis=-1, keepdims=True)
    return (h - mu) * lax.rsqrt(var + EPS) * g.astype(jnp.float32).reshape(MLSTM_HEADS, MLSTM_DH)


def softmax_lse(s):
    mx = jnp.max(s, axis=-1, keepdims=True)
    e = jnp.exp(s - mx)
    den = jnp.sum(e, axis=-1, keepdims=True)
    return e / den, (mx + jnp.log(den))[..., 0]


def causal_conv(u, buf, w, b):
    T = u.shape[1]
    up = jnp.concatenate([buf.astype(u.dtype), u], axis=1)
    y = b
    for j in range(CONV_W):
        y = y + up[:, j:j + T] * w[j]
    return y, up[:, -(CONV_W - 1):]


def mlstm_chunkwise(q, k, v, i_pre, logf, C0, n0, m0):
    B, T, H, E = q.shape
    L = math.gcd(T, CHUNK)
    nc = T // L
    causal = jnp.tril(jnp.ones((L, L), dtype=bool))

    def chunks(a):
        return jnp.moveaxis(a.reshape((B, nc, L) + a.shape[2:]), 1, 0)

    def step(carry, inp):
        C, n, m = carry
        qc, kc, vc, ic, fc = inp
        b = jnp.cumsum(fc, axis=1)
        a = b + m[:, None, :]
        dmat = b[:, :, None, :] - b[:, None, :, :] + ic[:, None, :, :]
        dmat = jnp.where(causal[None, :, :, None], dmat, -jnp.inf)
        mt = jnp.maximum(a, jnp.max(dmat, axis=2))
        wa = jnp.exp(a - mt)
        sc = jnp.einsum('bthe,bshe->btsh', qc, kc) * jnp.exp(dmat - mt[:, :, None, :])
        num = wa[..., None] * jnp.einsum('bthd,bhde->bthe', qc, C) + jnp.einsum('btsh,bshe->bthe', sc, vc)
        den = wa * jnp.einsum('bthd,bhd->bth', qc, n) + jnp.sum(sc, axis=2)
        h = num / jnp.maximum(jnp.abs(den), jnp.exp(-mt))[..., None]
        bl = b[:, -1]
        g = bl[:, None, :] - b + ic
        m_new = jnp.maximum(bl + m, jnp.max(g, axis=1))
        wc = jnp.exp(bl + m - m_new)
        ws = jnp.exp(g - m_new[:, None, :])
        C_new = wc[..., None, None] * C + jnp.einsum('bsh,bshd,bshe->bhde', ws, kc, vc)
        n_new = wc[..., None] * n + jnp.einsum('bsh,bshd->bhd', ws, kc)
        return (C_new, n_new, m_new), h

    (C, n, m), hs = lax.scan(step, (C0, n0, m0), tuple(chunks(a) for a in (q, k, v, i_pre, logf)))
    h = jnp.moveaxis(hs, 0, 1).reshape(B, T, H, E)
    return h, C, n, m


def combine_branches(outs, lses):
    w = jax.nn.softmax(jnp.stack(lses, axis=0), axis=0)
    return jnp.einsum('nbth,nbthe->bthe', w, jnp.stack(outs, axis=0))


def to_residue_blocks(a, d, n, npad, front):
    B, T, H, E = a.shape
    a = a.reshape(B, n, d, H, E).transpose(0, 2, 1, 3, 4)
    return jnp.pad(a, ((0, 0), (0, 0), (front, npad - n), (0, 0), (0, 0)))


def dilated_attention_prompt(q, k, v):
    B, T, H, E = q.shape
    scale = E ** -0.5
    outs, lses = [], []
    for window, d in DILATED:
        rel = window // d
        n = T // d
        nb = -(-n // BLK)
        npad = nb * BLK
        qs = to_residue_blocks(q, d, n, npad, 0).reshape(B, d, nb, BLK, H, E)
        ks = to_residue_blocks(k, d, n, npad, BLK).reshape(B, d, nb + 1, BLK, H, E)
        vs = to_residue_blocks(v, d, n, npad, BLK).reshape(B, d, nb + 1, BLK, H, E)
        kb = jnp.concatenate([ks[:, :, :-1], ks[:, :, 1:]], axis=3)
        vb = jnp.concatenate([vs[:, :, :-1], vs[:, :, 1:]], axis=3)
        s = jnp.einsum('bdnqhe,bdnkhe->bdnhqk', qs, kb) * scale
        qi = jnp.arange(BLK)[:, None]
        kj = jnp.arange(2 * BLK)[None, :]
        dist = qi + BLK - kj
        kpos = jnp.arange(nb)[:, None, None] * BLK + kj[None] - BLK
        valid = ((dist >= 0) & (dist <= rel))[None] & (kpos >= 0)
        s = jnp.where(valid[None, None, :, None], s, -jnp.inf)
        p, lse = softmax_lse(s)
        o = jnp.einsum('bdnhqk,bdnkhe->bdnqhe', p, vb).reshape(B, d, npad, H, E)[:, :, :n]
        outs.append(o.transpose(0, 2, 1, 3, 4).reshape(B, T, H, E))
        lse = lse.transpose(0, 1, 2, 4, 3).reshape(B, d, npad, H)[:, :, :n]
        lses.append(lse.transpose(0, 2, 1, 3).reshape(B, T, H))
    return combine_branches(outs, lses)


def dilated_attention_step(q, k_new, v_new, k_buf, v_buf):
    B, T, H, E = q.shape
    wb = k_buf.shape[1]
    scale = E ** -0.5
    kk = jnp.concatenate([k_buf.astype(jnp.float32), k_new], axis=1)
    vv = jnp.concatenate([v_buf.astype(jnp.float32), v_new], axis=1)
    t = jnp.arange(T)
    outs, lses = [], []
    for window, d in DILATED:
        r = jnp.arange(window // d + 1)
        idx = wb + t[:, None] - d * r[None, :]
        valid = idx >= 0
        idx = jnp.maximum(idx, 0)
        kg = kk[:, idx]
        vg = vv[:, idx]
        s = jnp.einsum('bthe,btrhe->bthr', q, kg) * scale
        s = jnp.where(valid[None, :, None, :], s, -jnp.inf)
        p, lse = softmax_lse(s)
        outs.append(jnp.einsum('bthr,btrhe->bthe', p, vg))
        lses.append(lse)
    return combine_branches(outs, lses)


def mixing_sublayer(x, conv_buf, C0, n0, m0, k_buf, v_buf, g_mix, w_in, conv_w, conv_b, b_gates, g_mh, w_out):
    B, T, _ = x.shape
    f32 = jnp.float32
    h = rmsnorm(x, g_mix)
    qm, km, vm, om, ig, fg, qa, ka, va = jnp.split(h @ w_in, SPLIT_POINTS, axis=-1)
    qk, new_conv = causal_conv(jnp.concatenate([qm, km], axis=-1), conv_buf, conv_w, conv_b)
    qk = jax.nn.silu(qk).astype(f32)
    qm, km = jnp.split(qk, 2, axis=-1)
    qm = qm.reshape(B, T, MLSTM_HEADS, MLSTM_DH)
    km = km.reshape(B, T, MLSTM_HEADS, MLSTM_DH) * (MLSTM_DH ** -0.5)
    vm = vm.astype(f32).reshape(B, T, MLSTM_HEADS, MLSTM_DH)
    gates = jnp.concatenate([ig, fg], axis=-1).astype(f32) + b_gates.astype(f32)
    i_pre, f_pre = jnp.split(gates, 2, axis=-1)
    logf = jax.nn.log_sigmoid(f_pre)
    hm, C, n, m = mlstm_chunkwise(qm, km, vm, i_pre, logf, C0.astype(f32), n0.astype(f32), m0.astype(f32))
    hm = headwise_layernorm(hm, g_mh).reshape(B, T, MLSTM_W) * jax.nn.sigmoid(om.astype(f32))
    qa = qa.astype(f32).reshape(B, T, ATTN_HEADS, ATTN_DH)
    ka = ka.astype(f32).reshape(B, T, ATTN_HEADS, ATTN_DH)
    va = va.astype(f32).reshape(B, T, ATTN_HEADS, ATTN_DH)
    if k_buf is None:
        ha = dilated_attention_prompt(qa, ka, va)
        keep = min(WINDOW_MAX, T)
        k_rows, v_rows = ka[:, T - keep:], va[:, T - keep:]
    else:
        ha = dilated_attention_step(qa, ka, va, k_buf, v_buf)
        k_rows, v_rows = ka, va
    mix = jnp.concatenate([hm, ha.reshape(B, T, ATTN_W)], axis=-1).astype(x.dtype)
    return x + mix @ w_out, (k_rows, v_rows, new_conv, C, n, m)


def memory_kv(mem, g_mem, w_mk, w_mv):
    B = mem.shape[0]
    h = rmsnorm(mem, g_mem)
    return ((h @ w_mk).reshape(B, MEM_LEN, MEM_HEADS, MEM_DH),
            (h @ w_mv).reshape(B, MEM_LEN, MEM_HEADS, MEM_DH))


def memory_xattn(x, mem_k, mem_v, g_xattn, w_mq, w_mo):
    B, T, _ = x.shape
    q = (rmsnorm(x, g_xattn) @ w_mq).astype(jnp.float32).reshape(B, T, MEM_HEADS, MEM_DH)
    s = jnp.einsum('bthe,bmhe->bhtm', q, mem_k.astype(jnp.float32)) * (MEM_DH ** -0.5)
    p = jax.nn.softmax(s, axis=-1)
    o = jnp.einsum('bhtm,bmhe->bthe', p, mem_v.astype(jnp.float32)).reshape(B, T, D_MODEL)
    return x + o.astype(x.dtype) @ w_mo


def swiglu_ffn(x, g_ffn, w_gate, w_up, w_down):
    h = rmsnorm(x, g_ffn)
    return x + (jax.nn.silu(h @ w_gate) * (h @ w_up)) @ w_down


def decoder_layer(x, mem_k, mem_v, conv_buf, C0, n0, m0, k_buf, v_buf, g_mix, w_in, conv_w, conv_b, b_gates,
                  g_mh, w_out, g_xattn, w_mq, w_mo, g_ffn, w_gate, w_up, w_down):
    x, st = mixing_sublayer(x, conv_buf, C0, n0, m0, k_buf, v_buf, g_mix, w_in, conv_w, conv_b, b_gates, g_mh, w_out)
    x = memory_xattn(x, mem_k, mem_v, g_xattn, w_mq, w_mo)
    x = swiglu_ffn(x, g_ffn, w_gate, w_up, w_down)
    return x, st


def setup_inputs(seed: int = 0) -> dict:
    key = jax.random.key(seed)
    ks = jax.random.split(key, 32)
    nrm = lambda i, shape, s=1.0: jax.random.normal(ks[i], shape, jnp.float32) * s
    wb = min(WINDOW_MAX, PAST_LEN)
    b_gates = jnp.concatenate([nrm(20, (MLSTM_HEADS,), 0.1),
                               jnp.linspace(3.0, 6.0, MLSTM_HEADS) + nrm(21, (MLSTM_HEADS,), 0.1)])
    return {
        'x_prompt': nrm(0, (BATCH, SEQ, D_MODEL)),
        'x_sample': nrm(1, (DEC_BATCH, DEC_SEQ, D_MODEL)),
        'mem_prompt': nrm(2, (BATCH, MEM_LEN, D_MODEL)),
        'cache_attn_k': nrm(3, (DEC_BATCH, wb, ATTN_HEADS, ATTN_DH)),
        'cache_attn_v': nrm(4, (DEC_BATCH, wb, ATTN_HEADS, ATTN_DH)),
        'cache_mem_k': nrm(5, (DEC_BATCH, MEM_LEN, MEM_HEADS, MEM_DH)),
        'cache_mem_v': nrm(6, (DEC_BATCH, MEM_LEN, MEM_HEADS, MEM_DH)),
        'state_conv': nrm(7, (DEC_BATCH, CONV_W - 1, 2 * MLSTM_W)),
        'state_C': nrm(8, (DEC_BATCH, MLSTM_HEADS, MLSTM_DH, MLSTM_DH), 0.1),
        'state_n': nrm(9, (DEC_BATCH, MLSTM_HEADS, MLSTM_DH), 0.1),
        'state_m': nrm(10, (DEC_BATCH, MLSTM_HEADS)),
        'g_mix': 1.0 + nrm(11, (D_MODEL,), 0.01),
        'w_in': nrm(12, (D_MODEL, N_IN), D_MODEL ** -0.5),
        'conv_w': nrm(13, (CONV_W, 2 * MLSTM_W), CONV_W ** -0.5),
        'conv_b': nrm(14, (2 * MLSTM_W,), 0.01),
        'b_gates': b_gates,
        'g_mh': 1.0 + nrm(15, (MLSTM_W,), 0.01),
        'w_out': nrm(16, (MIX_W, D_MODEL), MIX_W ** -0.5),
        'g_mem': 1.0 + nrm(17, (D_MODEL,), 0.01),
        'w_mk': nrm(18, (D_MODEL, D_MODEL), D_MODEL ** -0.5),
        'w_mv': nrm(19, (D_MODEL, D_MODEL), D_MODEL ** -0.5),
        'g_xattn': 1.0 + nrm(22, (D_MODEL,), 0.01),
        'w_mq': nrm(23, (D_MODEL, D_MODEL), D_MODEL ** -0.5),
        'w_mo': nrm(24, (D_MODEL, D_MODEL), D_MODEL ** -0.5),
        'g_ffn': 1.0 + nrm(25, (D_MODEL,), 0.01),
        'w_gate': nrm(26, (D_MODEL, D_FF), D_MODEL ** -0.5),
        'w_up': nrm(27, (D_MODEL, D_FF), D_MODEL ** -0.5),
        'w_down': nrm(28, (D_FF, D_MODEL), D_FF ** -0.5),
        'g_final': 1.0 + nrm(29, (D_MODEL,), 0.01),
    }


def reference(x_prompt, x_sample, mem_prompt, cache_attn_k, cache_attn_v, cache_mem_k, cache_mem_v,
              state_conv, state_C, state_n, state_m, g_mix, w_in, conv_w, conv_b, b_gates, g_mh, w_out,
              g_mem, w_mk, w_mv, g_xattn, w_mq, w_mo, g_ffn, w_gate, w_up, w_down, g_final):
    f32 = jnp.float32
    B = x_prompt.shape[0]
    p_mem_k, p_mem_v = memory_kv(mem_prompt, g_mem, w_mk, w_mv)
    conv0 = jnp.zeros((B, CONV_W - 1, 2 * MLSTM_W), x_prompt.dtype)
    C0 = jnp.zeros((B, MLSTM_HEADS, MLSTM_DH, MLSTM_DH), f32)
    n0 = jnp.zeros((B, MLSTM_HEADS, MLSTM_DH), f32)
    m0 = jnp.zeros((B, MLSTM_HEADS), f32)
    hp = x_prompt
    for _ in range(DEPTH):
        hp, (p_attn_k, p_attn_v, p_conv, p_C, p_n, p_m) = decoder_layer(
            hp, p_mem_k, p_mem_v, conv0, C0, n0, m0, None, None, g_mix, w_in, conv_w, conv_b, b_gates,
            g_mh, w_out, g_xattn, w_mq, w_mo, g_ffn, w_gate, w_up, w_down)
    y_prompt = rmsnorm(hp, g_final)
    hs = x_sample
    for _ in range(DEPTH):
        hs, (s_attn_k, s_attn_v, s_conv, s_C, s_n, s_m) = decoder_layer(
            hs, cache_mem_k, cache_mem_v, state_conv, state_C, state_n, state_m, cache_attn_k, cache_attn_v,
            g_mix, w_in, conv_w, conv_b, b_gates, g_mh, w_out, g_xattn, w_mq, w_mo, g_ffn, w_gate, w_up, w_down)
    y_sample = rmsnorm(hs, g_final)
    return (y_prompt, y_sample, p_attn_k, p_attn_v, p_conv, p_C, p_n, p_m, p_mem_k, p_mem_v,
            s_attn_k, s_attn_v, s_conv, s_C, s_n, s_m)
```

```cpp
#include <hip/hip_runtime.h>
#include <cstdio>
#include <cstdint>

#ifndef MK_N_LAUNCHES
#define MK_N_LAUNCHES 1
#endif

constexpr int DM = 1024, SEQ = 8192, NBATCH = 2, MP = NBATCH * SEQ, DBATCH = 128, DSEQ = 4, MSMP = DBATCH * DSEQ, MROWS = MP + MSMP;
constexpr int NZ = 3584, ZQ = 0, ZK = 512, ZV = 1024, ZO = 1536, ZQA = 2048, ZKA = 2560, ZVA = 3072;
constexpr int NIN = 3592, FF = 2816, NGU = 2 * FF, WB = 2048;
constexpr float EPS = 1e-6f;
constexpr int NCH = SEQ / 64;
constexpr size_t O_Y = 0, O_PATTK = (size_t)MROWS * DM, O_PATTV = O_PATTK + 2 * 2048 * 512, O_PCONV = O_PATTV + 2 * 2048 * 512, O_PC = O_PCONV + 2 * 3 * 1024,
                 O_PN = O_PC + 2 * 4 * 128 * 128, O_PM = O_PN + 2 * 4 * 128, O_PMEMK = O_PM + 8, O_PMEMV = O_PMEMK + 2 * 256 * 1024, O_SATTK = O_PMEMV + 2 * 256 * 1024,
                 O_SATTV = O_SATTK + (size_t)MSMP * 512, O_SCONV = O_SATTV + (size_t)MSMP * 512, O_SC = O_SCONV + (size_t)DBATCH * 3 * 1024, O_SN = O_SC + (size_t)DBATCH * 4 * 128 * 128,
                 O_SM = O_SN + (size_t)DBATCH * 4 * 128, O_END = O_SM + DBATCH * 4;
constexpr size_t MiB = 1u << 20;
constexpr size_t WS_CTL = 0, CTL_ZERO_BYTES = 1 * MiB;
constexpr size_t WS_WIN = 2 * MiB, WS_WOUT = 10 * MiB, WS_WMQ = 12 * MiB, WS_WMO = 14 * MiB, WS_WMKV = 16 * MiB, WS_WGU = 20 * MiB, WS_WDN = 32 * MiB;
constexpr size_t WS_GI = 39 * MiB, WS_GF = 39 * MiB + 512 * 1024, WS_SS = 40 * MiB;
constexpr size_t WS_LSUM = 41 * MiB, WS_MST = 41 * MiB + 64 * 1024, WS_NS = 41 * MiB + 512 * 1024;
constexpr size_t WS_MN = 42 * MiB, WS_MEMK = 43 * MiB, WS_MEMV = 44 * MiB;
constexpr size_t WS_XN = 48 * MiB, WS_Z = 82 * MiB, WS_QC = 198 * MiB, WS_KC = 214 * MiB, WS_DCX = 230 * MiB, WS_CS = 295 * MiB, WS_MIX = 328 * MiB;
constexpr size_t WS_X1 = 362 * MiB, WS_X1B = 428 * MiB, WS_QX = 462 * MiB, WS_OX = 496 * MiB, WS_X2 = 530 * MiB, WS_X2B = 596 * MiB, WS_H = 630 * MiB, WS_X3 = 722 * MiB, WS_END = 788 * MiB;
static_assert(WS_WIN + (size_t)NZ * DM * 2 <= WS_WOUT && WS_WGU + (size_t)NGU * DM * 2 <= WS_WDN && WS_WDN + (size_t)DM * FF * 2 <= WS_GI, "ws map: weights");
static_assert(WS_XN + (size_t)MROWS * DM * 2 <= WS_Z && WS_Z + (size_t)MROWS * NZ * 2 <= WS_QC && WS_DCX + (size_t)8 * NCH * 129 * 128 * 4 <= WS_CS && WS_CS + (size_t)8 * NCH * 16384 * 2 <= WS_MIX, "ws map: activations");
static_assert(WS_MIX + (size_t)MROWS * DM * 2 <= WS_X1 && WS_X1 + (size_t)MROWS * DM * 4 <= WS_X1B && WS_X1B + (size_t)MROWS * DM * 2 <= WS_QX && WS_H + (size_t)MROWS * FF * 2 <= WS_X3 && WS_X3 + (size_t)MROWS * DM * 4 <= WS_END, "ws map: tail");
constexpr int CW_BAR = 4096;
namespace pg8 {
#define PG8_LAS __attribute__((address_space(3)))
typedef unsigned short bf16_t;
typedef short bf16x8 __attribute__((ext_vector_type(8)));
typedef float f32x4 __attribute__((ext_vector_type(4)));
typedef unsigned u32x4 __attribute__((ext_vector_type(4)));
constexpr int BM = 256, BK = 64, HALF = 128, HTB = HALF * BK * 2  , STAGE_BYTES = 8 * HTB, NXCD = 8, WGM = 8;

__host__ __device__ __forceinline__ int lds_byte(int r, int c) { const int st = (r >> 4) * 2 + (c >> 5), rr = r & 15, cc = c & 31, ob = rr * 64 + cc * 2; return st * 1024 + (ob ^ (((ob >> 9) & 1) << 5)); }
__host__ __device__ __forceinline__ void stage_rc(int b, int& R, int& C) { const int st = b / 1024, sb = b % 1024, swz = sb ^ (((sb >> 9) & 1) << 5); R = (st >> 1) * 16 + swz / 64; C = (st & 1) * 32 + (swz % 64) / 2; }
__host__ __device__ __forceinline__ int perm32(int rho) { const int n = rho >> 4, i = rho & 15; return 8 * (i >> 2) + 4 * n + (i & 3); }

struct Unit { int pm, pn; };
struct Gemm { const bf16_t* A; const bf16_t* Bt; int M, N, K; };

struct StaticOrder {
    int nM, nN, nwg, G, c;
    __host__ __device__ void init(int M, int N, int G_, int c_) { nM = M / BM; nN = N / BM; nwg = nM * nN; G = G_; c = c_; }
    __host__ __device__ bool next(int i, Unit& u) const {
        const long L = (long)i * G + c; if (L >= nwg) return false;
        int wgid = (int)L; { const int q = nwg / NXCD, r = nwg % NXCD, xcd = wgid % NXCD, off = wgid / NXCD; wgid = (xcd < r ? xcd * (q + 1) : r * (q + 1) + (xcd - r) * q) + off; }
        const int nig = WGM * nN, gid = wgid / nig, fm = gid * WGM, gsz = (nM - fm) < WGM ? (nM - fm) : WGM;
        u.pm = fm + ((wgid % nig) % gsz); u.pn = (wgid % nig) / gsz; return true;
    }
    __device__ __forceinline__ void a_ready(const Unit&) const {}
    __device__ __forceinline__ void done(const Unit&) const {}
};

__device__ __forceinline__ unsigned cvt_pk_bf16(float lo, float hi) { unsigned r; asm volatile("v_cvt_pk_bf16_f32 %0, %1, %2" : "=v"(r) : "v"(lo), "v"(hi)); return r; }
typedef float f32x2 __attribute__((ext_vector_type(2)));
typedef unsigned u32x2 __attribute__((ext_vector_type(2)));
__device__ __forceinline__ u32x4 pack8(const f32x4 v0, const f32x4 v1) { u32x4 w; w.x = cvt_pk_bf16(v0[0], v0[1]); w.y = cvt_pk_bf16(v0[2], v0[3]); w.z = cvt_pk_bf16(v1[0], v1[1]); w.w = cvt_pk_bf16(v1[2], v1[3]); return w; }
struct EpiIn {
    static constexpr bool PERM = true, AFTER_DRAIN = false;
    bf16_t* Z; float* out;
    __device__ __forceinline__ void operator()(const f32x4 (&acc)[2][2][4][2], const Unit& u, int wr, int wc, int fr, int fq) const {
        const int row0 = u.pm * BM + wr * 64 + fr, col0 = u.pn * BM + wc * 32 + 8 * fq;
        const bool conv_t = (u.pn < 4) && (u.pm == 31 || u.pm >= 63);
        const bool kv_t = (u.pn >= 10);
        const int isv = (u.pn >= 12) ? 1 : 0;
#pragma unroll
        for (int ai = 0; ai < 2; ++ai)
#pragma unroll
            for (int m = 0; m < 4; ++m) {
                const int row = row0 + ai * HALF + m * 16;
                bf16_t* rowp = Z + (size_t)row * NZ + col0;
                float* side = nullptr;
                if (conv_t) {
                    if (row < MP) { const int t = row & (SEQ - 1); if (t >= SEQ - 3) side = out + O_PCONV + (size_t)((row >> 13) * 3 + (t - (SEQ - 3))) * 1024 + col0; }
                    else { const int s = row - MP, t = s & 3; if (t >= 1) side = out + O_SCONV + (size_t)((s >> 2) * 3 + (t - 1)) * 1024 + col0; }
                } else if (kv_t) {
                    const int c = col0 - (isv ? ZVA : ZKA);
                    if (row < MP) { const int t = row & (SEQ - 1); if (t >= SEQ - 2048) side = out + (isv ? O_PATTV : O_PATTK) + (size_t)((row >> 13) * 2048 + (t - (SEQ - 2048))) * 512 + c; }
                    else side = out + (isv ? O_SATTV : O_SATTK) + (size_t)(row - MP) * 512 + c;
                }
#pragma unroll
                for (int bj = 0; bj < 2; ++bj) { const f32x4 v0 = acc[ai][bj][m][0], v1 = acc[ai][bj][m][1];
                    *(u32x4*)(rowp + bj * HALF) = pack8(v0, v1);
                    if (side) { *(f32x4*)(side + bj * HALF) = v0; *(f32x4*)(side + bj * HALF + 4) = v1; } }
            }
    }
};
struct EpiMem {
    static constexpr bool PERM = true, AFTER_DRAIN = false;
    bf16_t* MK; bf16_t* MV; float* out;
    __device__ __forceinline__ void operator()(const f32x4 (&acc)[2][2][4][2], const Unit& u, int wr, int wc, int fr, int fq) const {
        const int row0 = u.pm * BM + wr * 64 + fr, isv = (u.pn >= 4) ? 1 : 0, col0 = u.pn * BM + wc * 32 + 8 * fq - isv * 1024;
        bf16_t* B = isv ? MV : MK; float* O = out + (isv ? O_PMEMV : O_PMEMK);
#pragma unroll
        for (int ai = 0; ai < 2; ++ai)
#pragma unroll
            for (int m = 0; m < 4; ++m) { const size_t off = (size_t)(row0 + ai * HALF + m * 16) * 1024 + col0;
#pragma unroll
                for (int bj = 0; bj < 2; ++bj) { const f32x4 v0 = acc[ai][bj][m][0], v1 = acc[ai][bj][m][1];
                    *(u32x4*)(B + off + bj * HALF) = pack8(v0, v1); *(f32x4*)(O + off + bj * HALF) = v0; *(f32x4*)(O + off + bj * HALF + 4) = v1; } }
    }
};
struct EpiRes {
    static constexpr bool PERM = false, AFTER_DRAIN = false;
    const float* base0; const float* base1; float* X; bf16_t* Xb; float* SS;
    __device__ __forceinline__ void operator()(const f32x4 (&acc)[2][2][4][2], const Unit& u, int wr, int wc, int fr, int fq) const {
        const int row0 = u.pm * BM + wr * 64 + fr, col0 = u.pn * BM + wc * 32 + 4 * fq;
#pragma unroll
        for (int ai = 0; ai < 2; ++ai)
#pragma unroll
            for (int m = 0; m < 4; ++m) { const int row = row0 + ai * HALF + m * 16;
                const float* bp = (row < MP ? base0 + (size_t)row * 1024 : base1 + (size_t)(row - MP) * 1024) + col0;
                const size_t off = (size_t)row * 1024 + col0; float ssq = 0.f;
#pragma unroll
                for (int bj = 0; bj < 2; ++bj)
#pragma unroll
                    for (int n = 0; n < 2; ++n) { const int o = bj * HALF + n * 16; const f32x4 v = *(const f32x4*)(bp + o) + acc[ai][bj][m][n];
                        *(f32x4*)(X + off + o) = v;
                        if (Xb) { u32x2 w; w.x = cvt_pk_bf16(v[0], v[1]); w.y = cvt_pk_bf16(v[2], v[3]); *(u32x2*)(Xb + off + o) = w; }
                        ssq += (v[0] * v[0] + v[1] * v[1]) + (v[2] * v[2] + v[3] * v[3]); }
                ssq += __shfl_xor(ssq, 16); ssq += __shfl_xor(ssq, 32);
                if (fq == 0) unsafeAtomicAdd(SS + row, ssq); }
    }
};
struct EpiQ {
    static constexpr bool PERM = true, AFTER_DRAIN = false;
    bf16_t* Q; const float* SS; float scale;
    __device__ __forceinline__ void operator()(const f32x4 (&acc)[2][2][4][2], const Unit& u, int wr, int wc, int fr, int fq) const {
        const int row0 = u.pm * BM + wr * 64 + fr, col0 = u.pn * BM + wc * 32 + 8 * fq;
#pragma unroll
        for (int ai = 0; ai < 2; ++ai)
#pragma unroll
            for (int m = 0; m < 4; ++m) { const int row = row0 + ai * HALF + m * 16; const float rs = __builtin_amdgcn_rsqf(SS[row] * (1.f / 1024.f) + 1e-6f) * scale;
#pragma unroll
                for (int bj = 0; bj < 2; ++bj) *(u32x4*)(Q + (size_t)row * 1024 + col0 + bj * HALF) = pack8(acc[ai][bj][m][0] * rs, acc[ai][bj][m][1] * rs); }
    }
};
struct EpiGU {
    static constexpr bool PERM = true, AFTER_DRAIN = false;
    bf16_t* H; const float* SS;
    __device__ __forceinline__ f32x4 swi(const f32x4 g, const f32x4 uu) const { f32x4 r;
#pragma unroll
        for (int i = 0; i < 4; ++i) r[i] = g[i] * __builtin_amdgcn_rcpf(1.f + __builtin_amdgcn_exp2f(-1.4426950408889634f * g[i])) * uu[i];
        return r; }
    __device__ __forceinline__ void operator()(const f32x4 (&acc)[2][2][4][2], const Unit& u, int wr, int wc, int fr, int fq) const {
        const int row0 = u.pm * BM + wr * 64 + fr, col0 = u.pn * HALF + wc * 32 + 8 * fq;
#pragma unroll
        for (int ai = 0; ai < 2; ++ai)
#pragma unroll
            for (int m = 0; m < 4; ++m) { const int row = row0 + ai * HALF + m * 16; const float rs = __builtin_amdgcn_rsqf(SS[row] * (1.f / 1024.f) + 1e-6f);
                const f32x4 h0 = swi(acc[ai][0][m][0] * rs, acc[ai][1][m][0] * rs), h1 = swi(acc[ai][0][m][1] * rs, acc[ai][1][m][1] * rs);
                *(u32x4*)(H + (size_t)row * FF + col0) = pack8(h0, h1); }
    }
};
template <class Epi, class Sched, bool ALIGN_EPI = false, bool SP2 = false>
__device__ __forceinline__ void gemm_phase(PG8_LAS unsigned char* lds, const Gemm g, const Sched& S, const Epi& E) {
    const int tid = threadIdx.x, wid = __builtin_amdgcn_readfirstlane(tid >> 6), lane = tid & 63, wr = wid >> 2, wc = wid & 3, fr = lane & 15, fq = lane >> 4;
    const int K = g.K, nt = K / BK;
    unsigned voffA[2], voffB[2];
#pragma unroll
    for (int i = 0; i < 2; ++i) { int R, C; stage_rc(tid * 16 + i * 8192, R, C); const int Rb = Epi::PERM ? ((R & ~31) + perm32(R & 31)) : R;
        voffA[i] = (unsigned)(R * K + C) * 2u; voffB[i] = (unsigned)(Rb * K + C) * 2u; }
    const size_t kstep = (size_t)(BK * 2);
    const size_t hstep = (size_t)HALF * K * 2;
    const size_t tstep = 2 * hstep;
    const unsigned ldsw = (unsigned)wid * 1024u;
    const int aoff = lds_byte(wr * 64 + fr, fq * 8), boff = lds_byte(wc * 32 + fr, fq * 8);
#define PG8_SA(b, h) (((b) * 2 + (h)) * HTB)
#define PG8_SB(b, h) ((4 + (b) * 2 + (h)) * HTB)
#define PG8_STAGE(bufoff, gbase, voff) do { _Pragma("unroll") for (int _i = 0; _i < 2; ++_i) \
        __builtin_amdgcn_global_load_lds((const unsigned*)((const char*)(gbase) + (voff)[_i]), (PG8_LAS unsigned*)(lds + (bufoff) + ldsw + _i * 8192), 16, 0, 0); } while (0)
#define PG8_LDA(dst, b, h) do { _Pragma("unroll") for (int m = 0; m < 4; ++m) _Pragma("unroll") for (int k = 0; k < 2; ++k) dst[m][k] = *(const PG8_LAS bf16x8*)(lds + PG8_SA(b, h) + aoff + m * 2048 + k * 1024); } while (0)
#define PG8_LDB(dst, b, h) do { _Pragma("unroll") for (int n = 0; n < 2; ++n) _Pragma("unroll") for (int k = 0; k < 2; ++k) dst[n][k] = *(const PG8_LAS bf16x8*)(lds + PG8_SB(b, h) + boff + n * 2048 + k * 1024); } while (0)
#define PG8_MMA(ai, bj, At, Bt) do { __builtin_amdgcn_s_setprio(1); _Pragma("unroll") for (int m = 0; m < 4; ++m) _Pragma("unroll") for (int n = 0; n < 2; ++n) _Pragma("unroll") for (int k = 0; k < 2; ++k) \
        acc[ai][bj][m][n] = __builtin_amdgcn_mfma_f32_16x16x32_bf16(Bt[n][k], At[m][k], acc[ai][bj][m][n], 0, 0, 0); __builtin_amdgcn_s_setprio(0); } while (0)
#define PG8_WAIT_V(n) asm volatile("s_waitcnt vmcnt(" #n ")" ::: "memory")
#define PG8_WAIT_L(n) asm volatile("s_waitcnt lgkmcnt(" #n ")" ::: "memory")
#define PG8_BAR __builtin_amdgcn_s_barrier()
#define PG8_SCHED __builtin_amdgcn_sched_barrier(0)
    Unit cur, nxt; int ui = 0;
    if (!S.next(0, cur)) return;
    f32x4 acc[2][2][4][2];
#pragma unroll
    for (int a = 0; a < 2; ++a)
#pragma unroll
        for (int b = 0; b < 2; ++b)
#pragma unroll
            for (int m = 0; m < 4; ++m)
#pragma unroll
                for (int n = 0; n < 2; ++n) acc[a][b][m][n] = (f32x4){0.f, 0.f, 0.f, 0.f};
    bf16x8 At[4][2], B0[2][2], B1[2][2];
    const char* cA = (const char*)g.A + (size_t)cur.pm * tstep; const char* cB = (const char*)g.Bt + (size_t)cur.pn * tstep;
    S.a_ready(cur);
    if constexpr (SP2) {
        PG8_STAGE(PG8_SB(0, 0), cB, voffB); PG8_STAGE(PG8_SB(0, 1), cB + hstep, voffB); PG8_STAGE(PG8_SA(0, 0), cA, voffA); PG8_STAGE(PG8_SA(0, 1), cA + hstep, voffA);
        if (wr == 1) PG8_BAR;
        PG8_WAIT_V(2); PG8_BAR;
        PG8_STAGE(PG8_SB(1, 0), cB + kstep, voffB); PG8_STAGE(PG8_SA(1, 0), cA + kstep, voffA); PG8_STAGE(PG8_SB(1, 1), cB + hstep + kstep, voffB);
        PG8_WAIT_V(6); PG8_BAR;
    } else {
        PG8_STAGE(PG8_SB(0, 0), cB, voffB); PG8_STAGE(PG8_SA(0, 0), cA, voffA); PG8_STAGE(PG8_SB(0, 1), cB + hstep, voffB); PG8_STAGE(PG8_SA(0, 1), cA + hstep, voffA);
        if (wr == 1) PG8_BAR;
        PG8_WAIT_V(4); PG8_BAR;
        PG8_STAGE(PG8_SB(1, 0), cB + kstep, voffB); PG8_STAGE(PG8_SA(1, 0), cA + kstep, voffA); PG8_STAGE(PG8_SB(1, 1), cB + hstep + kstep, voffB);
        PG8_WAIT_V(6); PG8_BAR;
    }
    for (;;) {
        const bool has_next = S.next(ui + 1, nxt);
        const char* nA = has_next ? (const char*)g.A + (size_t)nxt.pm * tstep : cA; const char* nB = has_next ? (const char*)g.Bt + (size_t)nxt.pn * tstep : cB;
        for (int t = 0; t < nt; t += 2) {
            const bool last = (t == nt - 2);
            const char* a1 = cA + (size_t)(t + 1) * kstep;
            const char* a2 = last ? nA : cA + (size_t)(t + 2) * kstep; const char* b2 = last ? nB : cB + (size_t)(t + 2) * kstep;
            const char* a3 = a2 + kstep; const char* b3 = b2 + kstep;
            if (last && has_next) S.a_ready(nxt);
            if constexpr (SP2) {
            PG8_LDB(B0, 0, 0); PG8_LDB(B1, 0, 1); PG8_SCHED; PG8_LDA(At, 0, 0); PG8_STAGE(PG8_SA(1, 1), a1 + hstep, voffA);
            PG8_WAIT_V(8); PG8_WAIT_L(0); PG8_BAR; PG8_MMA(0, 0, At, B0); PG8_MMA(0, 1, At, B1); PG8_BAR; PG8_SCHED;
            PG8_LDA(At, 0, 1); PG8_STAGE(PG8_SB(0, 0), b2, voffB); PG8_STAGE(PG8_SB(0, 1), b2 + hstep, voffB); PG8_STAGE(PG8_SA(0, 0), a2, voffA);
            PG8_WAIT_V(8); PG8_WAIT_L(0); PG8_BAR; PG8_MMA(1, 0, At, B0); PG8_MMA(1, 1, At, B1); PG8_BAR; PG8_SCHED;
            PG8_LDB(B0, 1, 0); PG8_LDB(B1, 1, 1); PG8_SCHED; PG8_LDA(At, 1, 0); PG8_STAGE(PG8_SA(0, 1), a2 + hstep, voffA);
            PG8_WAIT_V(8); PG8_WAIT_L(0); PG8_BAR; PG8_MMA(0, 0, At, B0); PG8_MMA(0, 1, At, B1); PG8_BAR; PG8_SCHED;
            PG8_LDA(At, 1, 1); PG8_STAGE(PG8_SB(1, 0), b3, voffB); PG8_STAGE(PG8_SB(1, 1), b3 + hstep, voffB); PG8_STAGE(PG8_SA(1, 0), a3, voffA);
            PG8_WAIT_V(8); PG8_WAIT_L(0); PG8_BAR; PG8_MMA(1, 0, At, B0); PG8_MMA(1, 1, At, B1); PG8_BAR; PG8_SCHED;
            } else {
            PG8_LDB(B0, 0, 0); PG8_SCHED; PG8_LDA(At, 0, 0); PG8_STAGE(PG8_SA(1, 1), a1 + hstep, voffA);
            PG8_WAIT_L(8); PG8_BAR; PG8_WAIT_L(0); PG8_MMA(0, 0, At, B0); PG8_BAR; PG8_SCHED;
            PG8_LDB(B1, 0, 1); PG8_STAGE(PG8_SB(0, 0), b2, voffB);
            PG8_BAR; PG8_WAIT_L(0); PG8_MMA(0, 1, At, B1); PG8_BAR;
            PG8_LDA(At, 0, 1); PG8_STAGE(PG8_SA(0, 0), a2, voffA);
            PG8_BAR; PG8_WAIT_L(0); PG8_MMA(1, 0, At, B0); PG8_BAR; PG8_SCHED;
            PG8_STAGE(PG8_SB(0, 1), b2 + hstep, voffB);
            PG8_WAIT_V(6); PG8_BAR; PG8_MMA(1, 1, At, B1); PG8_BAR;
            PG8_LDB(B0, 1, 0); PG8_SCHED; PG8_LDA(At, 1, 0); PG8_STAGE(PG8_SA(0, 1), a2 + hstep, voffA);
            PG8_WAIT_L(8); PG8_BAR; PG8_WAIT_L(0); PG8_MMA(0, 0, At, B0); PG8_BAR; PG8_SCHED;
            PG8_LDB(B1, 1, 1); PG8_STAGE(PG8_SB(1, 0), b3, voffB);
            PG8_BAR; PG8_WAIT_L(0); PG8_MMA(0, 1, At, B1); PG8_BAR;
            PG8_LDA(At, 1, 1); PG8_STAGE(PG8_SA(1, 0), a3, voffA);
            PG8_BAR; PG8_WAIT_L(0); PG8_MMA(1, 0, At, B0); PG8_BAR; PG8_SCHED;
            PG8_STAGE(PG8_SB(1, 1), b3 + hstep, voffB);
            PG8_WAIT_V(6); PG8_BAR; PG8_MMA(1, 1, At, B1); PG8_BAR;
            }
        }
        if constexpr (ALIGN_EPI) { if (wr == 0) PG8_BAR; }
        if constexpr (!Epi::AFTER_DRAIN) { E(acc, cur, wr, wc, fr, fq); S.done(cur); }
        if (!has_next) break;
#pragma unroll
        for (int a = 0; a < 2; ++a)
#pragma unroll
            for (int b = 0; b < 2; ++b)
#pragma unroll
                for (int m = 0; m < 4; ++m)
#pragma unroll
                    for (int n = 0; n < 2; ++n) acc[a][b][m][n] = (f32x4){0.f, 0.f, 0.f, 0.f};
        cur = nxt; cA = nA; cB = nB; ++ui;
        if constexpr (ALIGN_EPI) { if (wr == 1) PG8_BAR; }
    }
    PG8_WAIT_V(0);
    if constexpr (!ALIGN_EPI) { if (wr == 0) PG8_BAR; }
    PG8_BAR;
    if constexpr (Epi::AFTER_DRAIN) { E.fused(acc, cur, wr, wc, fr, fq, lds, wid, lane); S.done(cur); }
#undef PG8_SA
#undef PG8_SB
#undef PG8_STAGE
#undef PG8_LDA
#undef PG8_LDB
#undef PG8_MMA
#undef PG8_WAIT_V
#undef PG8_WAIT_L
#undef PG8_BAR
#undef PG8_SCHED
}
}
#define GAS __attribute__((address_space(1)))
#define LAS __attribute__((address_space(3)))
typedef unsigned short bf16;
typedef float f32x4 __attribute__((ext_vector_type(4)));
typedef float f32x2 __attribute__((ext_vector_type(2)));
typedef short bf16x8 __attribute__((ext_vector_type(8)));
typedef short s16x4 __attribute__((ext_vector_type(4)));
typedef unsigned u32x4 __attribute__((ext_vector_type(4)));
typedef unsigned u32x2 __attribute__((ext_vector_type(2)));
typedef GAS unsigned gu32;
#define RLX_AGENT __ATOMIC_RELAXED, __HIP_MEMORY_SCOPE_AGENT
#define LDS_WAIT() asm volatile("s_waitcnt lgkmcnt(0)" ::: "memory")
#define MFMA16(a, b, c) __builtin_amdgcn_mfma_f32_16x16x32_bf16((a), (b), (c), 0, 0, 0)
constexpr float LOG2E = 1.4426950408889634f;
__device__ __forceinline__ unsigned pk2(float lo, float hi) { typedef __bf16 b2 __attribute__((ext_vector_type(2))); const f32x2 v = {lo, hi}; const b2 b = __builtin_convertvector(v, b2); return __builtin_bit_cast(unsigned, b); }
__device__ __forceinline__ float bflo(unsigned w) { return __uint_as_float(w << 16); }
__device__ __forceinline__ float bfhi(unsigned w) { return __uint_as_float(w & 0xffff0000u); }
__device__ __forceinline__ float bf2f(bf16 h) { return __uint_as_float((unsigned)h << 16); }
__device__ __forceinline__ u32x4 pk8(const f32x4 a, const f32x4 b) { u32x4 w; w.x = pk2(a[0], a[1]); w.y = pk2(a[2], a[3]); w.z = pk2(b[0], b[1]); w.w = pk2(b[2], b[3]); return w; }
__device__ __forceinline__ bf16x8 asfrag(const u32x4 w) { return __builtin_bit_cast(bf16x8, w); }
__device__ __forceinline__ float ex2(float x) { return __builtin_amdgcn_exp2f(x); }
__device__ __forceinline__ float fexp(float x) { return __builtin_amdgcn_exp2f(x * LOG2E); }
__device__ __forceinline__ float wave_sum(float v) {
#pragma unroll
    for (int o = 1; o < 64; o <<= 1) v += __shfl_xor(v, o);
    return v; }
__device__ __forceinline__ float wave_max(float v) {
#pragma unroll
    for (int o = 1; o < 64; o <<= 1) v = fmaxf(v, __shfl_xor(v, o));
    return v; }
__device__ __forceinline__ float wave_scan_sum(float v, int lane) {
#pragma unroll
    for (int o = 1; o < 64; o <<= 1) { const float t = __shfl_up(v, o); if (lane >= o) v += t; }
    return v; }
__device__ __forceinline__ float wave_scan_max(float v, int lane) {
#pragma unroll
    for (int o = 1; o < 64; o <<= 1) { const float t = __shfl_up(v, o); if (lane >= o) v = fmaxf(v, t); }
    return v; }
__device__ __forceinline__ float xsum4(float v) { v += __shfl_xor(v, 16); v += __shfl_xor(v, 32); return v; }
__device__ __forceinline__ float xmax4(float v) { v = fmaxf(v, __shfl_xor(v, 16)); v = fmaxf(v, __shfl_xor(v, 32)); return v; }
__device__ __forceinline__ bf16x8 tr_frag(const LAS unsigned char* img, int rowbytes, int row0, int col0, int lane) {
    const int g = lane >> 4, l16 = lane & 15, q = l16 >> 2, p = l16 & 3;
    const LAS unsigned char* a = img + (row0 + 8 * g + q) * rowbytes + (col0 + 4 * p) * 2;
    const s16x4 lo = __builtin_amdgcn_ds_read_tr16_b64_v4i16((LAS s16x4*)a);
    const s16x4 hi = __builtin_amdgcn_ds_read_tr16_b64_v4i16((LAS s16x4*)(a + 4 * rowbytes));
    return (bf16x8){lo[0], lo[1], lo[2], lo[3], hi[0], hi[1], hi[2], hi[3]};
}

struct Params {
    const float *x_prompt, *x_sample, *mem_prompt, *cache_k, *cache_v, *cmem_k, *cmem_v, *st_conv, *st_C, *st_n, *st_m, *g_mix, *w_in, *conv_w, *conv_b, *b_gates, *g_mh, *w_out,
                *g_mem, *w_mk, *w_mv, *g_xattn, *w_mq, *w_mo, *g_ffn, *w_gate, *w_up, *w_down, *g_final;
    float* out; unsigned char* ws; int ph_lo, ph_hi, li, pad;
};
struct Ctx { int tid, lane, wave, vcu, G; LAS unsigned char* W; };

__device__ __forceinline__ void p0_transpose_item(const float* W, const float* gk, int K, int N, int n0s, bf16* WT, int n0d, int k0, LAS float* scr, int lane) {
#pragma unroll 8
    for (int i = 0; i < 32; ++i) { const int kk = 2 * i + (lane >> 5); const float gs = gk ? gk[k0 + kk] : 1.f; scr[kk * 33 + (lane & 31)] = gs * W[(size_t)(k0 + kk) * N + n0s + (lane & 31)]; }
    LDS_WAIT(); asm volatile("" ::: "memory");
    const int c = lane & 7;
#pragma unroll
    for (int j = 0; j < 4; ++j) { const int n = (lane >> 3) + 8 * j; const LAS float* s = scr + (8 * c) * 33 + n;
        u32x4 o; o.x = pk2(s[0 * 33], s[1 * 33]); o.y = pk2(s[2 * 33], s[3 * 33]); o.z = pk2(s[4 * 33], s[5 * 33]); o.w = pk2(s[6 * 33], s[7 * 33]);
        *(u32x4*)(WT + (size_t)(n0d + n) * K + k0 + 8 * c) = o; }
    LDS_WAIT(); asm volatile("" ::: "memory");
}
__device__ __forceinline__ void ph0_prologue(const Params& P, const Ctx& C) {
    unsigned char* ws = P.ws; const int tid = C.tid, lane = C.lane;
    { float* ss = (float*)(ws + WS_SS); for (int i = C.vcu * 512 + tid; i < 3 * MROWS; i += C.G * 512) ss[i] = 0.f; }
    LAS float* wg = (LAS float*)C.W;
    for (int i = tid; i < 1024 * 8; i += 512) { const int k = i >> 3, j = i & 7; wg[j * 1024 + k] = P.g_mix[k] * P.w_in[(size_t)k * NIN + 2048 + j]; }
    __syncthreads();
    bf16* XN = (bf16*)(ws + WS_XN); bf16* MN = (bf16*)(ws + WS_MN); float* GI = (float*)(ws + WS_GI); float* GF = (float*)(ws + WS_GF);
    const int gw = C.vcu * 8 + C.wave, NGW = C.G * 8;
    for (int m = gw; m < MROWS + 512; m += NGW) {
        const float* xr = m < MP ? P.x_prompt + (size_t)m * DM : (m < MROWS ? P.x_sample + (size_t)(m - MP) * DM : P.mem_prompt + (size_t)(m - MROWS) * DM);
        f32x4 v[4]; float s = 0.f;
#pragma unroll
        for (int j = 0; j < 4; ++j) { v[j] = ((const f32x4*)xr)[lane + 64 * j]; s += (v[j][0] * v[j][0] + v[j][1] * v[j][1]) + (v[j][2] * v[j][2] + v[j][3] * v[j][3]); }
        const float rstd = 1.0f / sqrtf(wave_sum(s) * (1.f / DM) + EPS);
        bf16* orow = m < MROWS ? XN + (size_t)m * DM : MN + (size_t)(m - MROWS) * DM;
#pragma unroll
        for (int j = 0; j < 4; ++j) { v[j] = v[j] * rstd; u32x2 w; w.x = pk2(v[j][0], v[j][1]); w.y = pk2(v[j][2], v[j][3]); ((u32x2*)orow)[lane + 64 * j] = w; }
        if (m < MROWS) {
            float a[8];
#pragma unroll
            for (int jj = 0; jj < 8; ++jj) { float t = 0.f;
#pragma unroll
                for (int j = 0; j < 4; ++j) { const f32x4 w4 = *(const LAS f32x4*)(wg + jj * 1024 + 256 * j + 4 * lane); t += (v[j][0] * w4[0] + v[j][1] * w4[1]) + (v[j][2] * w4[2] + v[j][3] * w4[3]); }
                a[jj] = wave_sum(t); }
            if (lane < 4) {
                const float ip = (lane == 0 ? a[0] : lane == 1 ? a[1] : lane == 2 ? a[2] : a[3]) + P.b_gates[lane];
                const float fp = (lane == 0 ? a[4] : lane == 1 ? a[5] : lane == 2 ? a[6] : a[7]) + P.b_gates[4 + lane];
                GI[(size_t)m * 4 + lane] = ip;
                GF[(size_t)m * 4 + lane] = fminf(fp, 0.f) - log1pf(__expf(-fabsf(fp)));
            }
        }
    }
    __syncthreads();
    LAS float* scr = (LAS float*)(C.W + C.wave * 16384);
    bf16* WIN = (bf16*)(ws + WS_WIN); bf16* WOUT = (bf16*)(ws + WS_WOUT); bf16* WMQ = (bf16*)(ws + WS_WMQ); bf16* WMO = (bf16*)(ws + WS_WMO); bf16* WMKV = (bf16*)(ws + WS_WMKV);
    bf16* WGU = (bf16*)(ws + WS_WGU); bf16* WDN = (bf16*)(ws + WS_WDN);
    constexpr int I_IN = 16 * 112, I_SQ = 16 * 32, I_FF = 16 * 88, I_DN = 44 * 32, NITEMS = I_IN + 5 * I_SQ + 2 * I_FF + I_DN;
    for (int it = gw; it < NITEMS; it += NGW) {
        int r = it;
        if (r < I_IN) { const int kb = r / 112, nd = (r % 112) * 32; p0_transpose_item(P.w_in, P.g_mix, DM, NIN, nd < 2048 ? nd : nd + 8, WIN, nd, kb * 64, scr, lane); continue; } r -= I_IN;
        if (r < I_SQ) { p0_transpose_item(P.w_out, nullptr, DM, DM, (r % 32) * 32, WOUT, (r % 32) * 32, (r / 32) * 64, scr, lane); continue; } r -= I_SQ;
        if (r < I_SQ) { p0_transpose_item(P.w_mk, P.g_mem, DM, DM, (r % 32) * 32, WMKV, (r % 32) * 32, (r / 32) * 64, scr, lane); continue; } r -= I_SQ;
        if (r < I_SQ) { p0_transpose_item(P.w_mv, P.g_mem, DM, DM, (r % 32) * 32, WMKV, 1024 + (r % 32) * 32, (r / 32) * 64, scr, lane); continue; } r -= I_SQ;
        if (r < I_SQ) { p0_transpose_item(P.w_mq, P.g_xattn, DM, DM, (r % 32) * 32, WMQ, (r % 32) * 32, (r / 32) * 64, scr, lane); continue; } r -= I_SQ;
        if (r < I_SQ) { p0_transpose_item(P.w_mo, nullptr, DM, DM, (r % 32) * 32, WMO, (r % 32) * 32, (r / 32) * 64, scr, lane); continue; } r -= I_SQ;
        if (r < I_FF) { const int c0 = (r % 88) * 32; p0_transpose_item(P.w_gate, P.g_ffn, DM, FF, c0, WGU, (c0 >> 7) * 256 + (c0 & 127), (r / 88) * 64, scr, lane); continue; } r -= I_FF;
        if (r < I_FF) { const int c0 = (r % 88) * 32; p0_transpose_item(P.w_up, P.g_ffn, DM, FF, c0, WGU, (c0 >> 7) * 256 + 128 + (c0 & 127), (r / 88) * 64, scr, lane); continue; } r -= I_FF;
        p0_transpose_item(P.w_down, nullptr, FF, DM, (r % 32) * 32, WDN, (r % 32) * 32, (r / 32) * 64, scr, lane);
    }
}

__device__ __forceinline__ void ph2_mlstm_local(const Params& P, const Ctx& C) {
    unsigned char* ws = P.ws; const int tid = C.tid, lane = C.lane, wave = C.wave;
    constexpr int RB = 272;
    LAS unsigned char* KW = C.W; LAS unsigned char* VI = C.W + 64 * RB; LAS float* wS = (LAS float*)(C.W + 128 * RB); LAS float* part = wS + 64;
    const bf16* Z = (const bf16*)(ws + WS_Z); const float* GI = (const float*)(ws + WS_GI); const float* GF = (const float*)(ws + WS_GF);
    bf16* QC = (bf16*)(ws + WS_QC); bf16* KC = (bf16*)(ws + WS_KC); float* DCX = (float*)(ws + WS_DCX); float* LSUM = (float*)(ws + WS_LSUM);
    for (int u = C.vcu; u < 8 * NCH; u += C.G) {
        const int bh = u >> 7, c = u & 127, b = bh >> 2, h = bh & 3; const int row0 = b * SEQ + c * 64;
        if (wave == 0) {
            const float ig = GI[(size_t)(row0 + lane) * 4 + h], lf = GF[(size_t)(row0 + lane) * 4 + h];
            const float bs = wave_scan_sum(lf, lane); const float Bc = __shfl(bs, 63); const float gg = Bc - bs + ig; const float Gm = wave_max(gg);
            wS[lane] = fexp(gg - Gm);
            if (lane == 0) { LSUM[(bh * NCH + c) * 2] = Bc; LSUM[(bh * NCH + c) * 2 + 1] = Gm; }
        }
        { const int r = tid >> 3, ch = tid & 7; const bf16* src = Z + (size_t)(row0 + r) * NZ + ZV + h * 128 + ch * 16;
          const u32x4 a = *(const u32x4*)src, bb = *(const u32x4*)(src + 8); *(LAS u32x4*)(VI + r * RB + ch * 32) = a; *(LAS u32x4*)(VI + r * RB + ch * 32 + 16) = bb; }
        __syncthreads();
        { const int cg = tid & 31, tg = tid >> 5; const bool isk = cg >= 16; const int ch = isk ? 512 + h * 128 + (cg - 16) * 8 : h * 128 + cg * 8; const int tl0 = tg * 4;
          float raw[7][8];
#pragma unroll
          for (int jr = 0; jr < 7; ++jr) { const int t = c * 64 + tl0 - 3 + jr; u32x4 w = {0u, 0u, 0u, 0u};
              if (t >= 0) w = *(const u32x4*)(Z + (size_t)(b * SEQ + t) * NZ + ch);
              raw[jr][0] = bflo(w.x); raw[jr][1] = bfhi(w.x); raw[jr][2] = bflo(w.y); raw[jr][3] = bfhi(w.y); raw[jr][4] = bflo(w.z); raw[jr][5] = bfhi(w.z); raw[jr][6] = bflo(w.w); raw[jr][7] = bfhi(w.w); }
          float cw[4][8], cb[8];
#pragma unroll
          for (int j = 0; j < 4; ++j) { const f32x4 a = *(const f32x4*)(P.conv_w + j * 1024 + ch), bq = *(const f32x4*)(P.conv_w + j * 1024 + ch + 4);
              cw[j][0] = a[0]; cw[j][1] = a[1]; cw[j][2] = a[2]; cw[j][3] = a[3]; cw[j][4] = bq[0]; cw[j][5] = bq[1]; cw[j][6] = bq[2]; cw[j][7] = bq[3]; }
          { const f32x4 a = *(const f32x4*)(P.conv_b + ch), bq = *(const f32x4*)(P.conv_b + ch + 4); cb[0] = a[0]; cb[1] = a[1]; cb[2] = a[2]; cb[3] = a[3]; cb[4] = bq[0]; cb[5] = bq[1]; cb[6] = bq[2]; cb[7] = bq[3]; }
#pragma unroll
          for (int tt = 0; tt < 4; ++tt) { float y[8];
#pragma unroll
              for (int i = 0; i < 8; ++i) { float a = cb[i];
#pragma unroll
                  for (int j = 0; j < 4; ++j) a += cw[j][i] * raw[tt + j][i];
                  y[i] = a * __builtin_amdgcn_rcpf(1.f + fexp(-a)); }
              const size_t orow = (size_t)(row0 + tl0 + tt) * 512;
              if (!isk) { u32x4 w; w.x = pk2(y[0], y[1]); w.y = pk2(y[2], y[3]); w.z = pk2(y[4], y[5]); w.w = pk2(y[6], y[7]); *(u32x4*)(QC + orow + h * 128 + cg * 8) = w; }
              else { const float ks = 0.08838834764831845f;
#pragma unroll
                  for (int i = 0; i < 8; ++i) y[i] *= ks;
                  u32x4 w; w.x = pk2(y[0], y[1]); w.y = pk2(y[2], y[3]); w.z = pk2(y[4], y[5]); w.w = pk2(y[6], y[7]); *(u32x4*)(KC + orow + h * 128 + (cg - 16) * 8) = w;
                  const float sw = wS[tl0 + tt];
                  u32x4 w2; w2.x = pk2(y[0] * sw, y[1] * sw); w2.y = pk2(y[2] * sw, y[3] * sw); w2.z = pk2(y[4] * sw, y[5] * sw); w2.w = pk2(y[6] * sw, y[7] * sw);
                  *(LAS u32x4*)(KW + (tl0 + tt) * RB + (cg - 16) * 16) = w2; } }
        }
        __syncthreads();
        { f32x4 acc[8];
#pragma unroll
          for (int et = 0; et < 8; ++et) acc[et] = (f32x4){0.f, 0.f, 0.f, 0.f};
#pragma unroll
          for (int ks = 0; ks < 2; ++ks) { const bf16x8 A = tr_frag(KW, RB, 32 * ks, 16 * wave, lane);
#pragma unroll
              for (int et = 0; et < 8; ++et) { const bf16x8 Bf = tr_frag(VI, RB, 32 * ks, 16 * et, lane); acc[et] = MFMA16(A, Bf, acc[et]); } }
          const int l16 = lane & 15, g = lane >> 4;
#pragma unroll
          for (int et = 0; et < 8; ++et) *(f32x4*)(DCX + ((size_t)(bh * NCH + c) * 129 + 16 * et + l16) * 128 + 16 * wave + 4 * g) = acc[et]; }
        { const int d = tid & 127, sg = tid >> 7; float s = 0.f;
#pragma unroll
          for (int ss = 0; ss < 16; ++ss) s += bf2f(*(const LAS bf16*)(KW + (sg * 16 + ss) * RB + d * 2));
          part[sg * 128 + d] = s; }
        __syncthreads();
        if (tid < 128) DCX[((size_t)(bh * NCH + c) * 129 + 128) * 128 + tid] = (part[tid] + part[128 + tid]) + (part[256 + tid] + part[384 + tid]);
        __syncthreads();
    }
}

__device__ __forceinline__ void ph3_scan_unit(const Params& P, const Ctx& C, int u) {
    unsigned char* ws = P.ws;
    const int gid = u * 512 + C.tid; if (gid >= 8 * 16512) return;
    const int bh = gid / 16512, idx = gid - bh * 16512;
    const float* DCX = (const float*)(ws + WS_DCX) + (size_t)bh * NCH * 16512 + idx; const float* LS = (const float*)(ws + WS_LSUM) + bh * NCH * 2;
    bf16* CS = (bf16*)(ws + WS_CS) + (size_t)bh * NCH * 16384 + idx; float* NS = (float*)(ws + WS_NS) + (size_t)bh * NCH * 128 + (idx - 16384); float* MST = (float*)(ws + WS_MST) + bh * NCH;
    float m = 0.f, st = 0.f;
#pragma unroll 8
    for (int c = 0; c < NCH; ++c) {
        const float x = DCX[(size_t)c * 16512]; const float Bc = LS[2 * c], Gc = LS[2 * c + 1];
        if (idx < 16384) CS[(size_t)c * 16384] = (bf16)(pk2(st, 0.f) & 0xffffu); else NS[(size_t)c * 128] = st;
        if (idx == 0) MST[c] = m;
        const float mn = fmaxf(m + Bc, Gc); const float wc = fexp(m + Bc - mn), wsx = fexp(Gc - mn);
        st = wc * st + wsx * x; m = mn;
    }
    if (idx < 16384) { const int e = idx >> 7, d = idx & 127; P.out[O_PC + ((size_t)bh * 128 + d) * 128 + e] = st; }
    else P.out[O_PN + bh * 128 + (idx - 16384)] = st;
    if (idx == 0) P.out[O_PM + bh] = m;
}

constexpr float ATT_SCL = 0.125f * LOG2E;
__device__ __forceinline__ void ph3_attn_prompt_unit(const Params& P, const Ctx& C, int u) {
    unsigned char* ws = P.ws; const int lane = C.lane, wave = C.wave;
    const int b = u >> 8, h = (u >> 5) & 7, blk = u & 31; const int T0 = blk * 256; const size_t rowb = (size_t)b * SEQ;
    const bf16* Z = (const bf16*)(ws + WS_Z); bf16* MIX = (bf16*)(ws + WS_MIX);
    LAS float* Ost = (LAS float*)C.W; LAS float* Mst = (LAS float*)(C.W + 69632); LAS float* Lst = Mst + 256; LAS unsigned char* Vst = C.W + 71680 + wave * 4608;
    const int g = lane >> 4, l16 = lane & 15;
    for (int br = 0; br < 3; ++br) {
        const int sh = 2 * br, dil = 1 << sh;
        for (int j = 0; j < 2; ++j) {
            const int st = 2 * wave + j;
            const int base = (br == 0) ? 16 * st : (br == 1) ? 64 * (st >> 2) + (st & 3) : st;
            const int tokl = base + (l16 << sh);
            const bf16* qp = Z + (rowb + T0 + tokl) * NZ + ZQA + h * 64 + 8 * g;
            const bf16x8 q0 = *(const bf16x8*)qp, q1 = *(const bf16x8*)(qp + 32);
            float m_run, l_run; f32x4 O[4];
            if (br == 0) { m_run = -1e30f; l_run = 0.f;
#pragma unroll
                for (int dt = 0; dt < 4; ++dt) O[dt] = (f32x4){0.f, 0.f, 0.f, 0.f}; }
            else { m_run = Mst[tokl]; l_run = (g == 0) ? Lst[tokl] : 0.f;
#pragma unroll
                for (int dt = 0; dt < 4; ++dt) O[dt] = *(const LAS f32x4*)(Ost + tokl * 68 + 16 * dt + 4 * g); }
            for (int ks = 0; ks < 5; ++ks) {
                const int kb = -144 + 32 * ks;
                f32x4 S[2];
#pragma unroll
                for (int hf = 0; hf < 2; ++hf) { const int kap = kb + 8 * (l16 >> 2) + 4 * hf + (l16 & 3); int kt = T0 + base + kap * dil; kt = kt < 0 ? 0 : kt;
                    const bf16* kp = Z + (rowb + kt) * NZ + ZKA + h * 64 + 8 * g; const bf16x8 k0 = *(const bf16x8*)kp, k1 = *(const bf16x8*)(kp + 32);
                    S[hf] = MFMA16(k0, q0, ((f32x4){0.f, 0.f, 0.f, 0.f})); S[hf] = MFMA16(k1, q1, S[hf]); }
#pragma unroll
                for (int it = 0; it < 4; ++it) { const int rho = it * 8 + (lane >> 3), ch = lane & 7; int kt = T0 + base + (kb + rho) * dil; kt = kt < 0 ? 0 : kt;
                    const u32x4 v = *(const u32x4*)(Z + (rowb + kt) * NZ + ZVA + h * 64 + ch * 8); *(LAS u32x4*)(Vst + rho * 144 + ch * 16) = v; }
                float s[8]; float mx = -INFINITY;
#pragma unroll
                for (int hf = 0; hf < 2; ++hf)
#pragma unroll
                    for (int ii = 0; ii < 4; ++ii) { const int kap = kb + 8 * g + 4 * hf + ii; const int dist = l16 - kap; const int ktok = T0 + base + kap * dil;
                        const bool ok = (dist >= 0) && (dist <= 128) && (ktok >= 0); const float sv = ok ? S[hf][ii] * ATT_SCL : -INFINITY; s[hf * 4 + ii] = sv; mx = fmaxf(mx, sv); }
                mx = xmax4(mx);
                const float mn = fmaxf(m_run, mx); const float alpha = ex2(m_run - mn); m_run = mn;
                float ps = 0.f;
#pragma unroll
                for (int i = 0; i < 8; ++i) { s[i] = ex2(s[i] - mn); ps += s[i]; }
                l_run = l_run * alpha + ps;
#pragma unroll
                for (int dt = 0; dt < 4; ++dt) O[dt] = O[dt] * alpha;
                u32x4 pw; pw.x = pk2(s[0], s[1]); pw.y = pk2(s[2], s[3]); pw.z = pk2(s[4], s[5]); pw.w = pk2(s[6], s[7]);
                const bf16x8 pf = asfrag(pw);
#pragma unroll
                for (int dt = 0; dt < 4; ++dt) { const bf16x8 vf = tr_frag(Vst, 144, 0, 16 * dt, lane); O[dt] = MFMA16(vf, pf, O[dt]); }
            }
            const float lt = xsum4(l_run);
            if (br < 2) {
#pragma unroll
                for (int dt = 0; dt < 4; ++dt) *(LAS f32x4*)(Ost + tokl * 68 + 16 * dt + 4 * g) = O[dt];
                if (g == 0) { Mst[tokl] = m_run; Lst[tokl] = lt; }
            } else { const float inv = 1.f / lt; bf16* op = MIX + (rowb + T0 + tokl) * DM + 512 + h * 64 + 4 * g;
#pragma unroll
                for (int dt = 0; dt < 4; ++dt) { u32x2 w; w.x = pk2(O[dt][0] * inv, O[dt][1] * inv); w.y = pk2(O[dt][2] * inv, O[dt][3] * inv); *(u32x2*)(op + 16 * dt) = w; } }
        }
        __syncthreads();
    }
}

__device__ __forceinline__ int samp_pos(int v) { return v < 384 ? 16 * (v >> 2) + (v & 3) : 1152 + v; }
__device__ __forceinline__ void ph3_attn_sample_unit(const Params& P, const Ctx& C, int db) {
    unsigned char* ws = P.ws; const int lane = C.lane, h = C.wave; const int g = lane >> 4, l16 = lane & 15; const int tq = l16 < 3 ? l16 : 3;
    const bf16* Z = (const bf16*)(ws + WS_Z); bf16* MIX = (bf16*)(ws + WS_MIX);
    const size_t srow = (size_t)MP + db * 4;
    LAS unsigned char* Vst = C.W + C.wave * 4608;
    const bf16* qp = Z + (srow + tq) * NZ + ZQA + h * 64 + 8 * g;
    const bf16x8 q0 = *(const bf16x8*)qp, q1 = *(const bf16x8*)(qp + 32);
    const float* ck = P.cache_k + (size_t)db * WB * 512 + h * 64; const float* cv = P.cache_v + (size_t)db * WB * 512 + h * 64;
    float m_run = -1e30f, l_run = 0.f; f32x4 O[4];
#pragma unroll
    for (int dt = 0; dt < 4; ++dt) O[dt] = (f32x4){0.f, 0.f, 0.f, 0.f};
    for (int ks = 0; ks < 29; ++ks) {
        f32x4 S[2];
#pragma unroll
        for (int hf = 0; hf < 2; ++hf) { const int v = 32 * ks + 8 * (l16 >> 2) + 4 * hf + (l16 & 3); u32x4 k0 = {0u, 0u, 0u, 0u}, k1 = {0u, 0u, 0u, 0u};
            if (v < 896) { const float* kp = ck + (size_t)samp_pos(v) * 512 + 8 * g; k0 = pk8(*(const f32x4*)kp, *(const f32x4*)(kp + 4)); k1 = pk8(*(const f32x4*)(kp + 32), *(const f32x4*)(kp + 36)); }
            else if (v < 900) { const bf16* kp = Z + (srow + (v - 896)) * NZ + ZKA + h * 64 + 8 * g; k0 = *(const u32x4*)kp; k1 = *(const u32x4*)(kp + 32); }
            S[hf] = MFMA16(asfrag(k0), q0, ((f32x4){0.f, 0.f, 0.f, 0.f})); S[hf] = MFMA16(asfrag(k1), q1, S[hf]); }
#pragma unroll
        for (int it = 0; it < 4; ++it) { const int rho = it * 8 + (lane >> 3), ch = lane & 7; const int v = 32 * ks + rho; u32x4 w = {0u, 0u, 0u, 0u};
            if (v < 896) { const float* vp = cv + (size_t)samp_pos(v) * 512 + ch * 8; w = pk8(*(const f32x4*)vp, *(const f32x4*)(vp + 4)); }
            else if (v < 900) w = *(const u32x4*)(Z + (srow + (v - 896)) * NZ + ZVA + h * 64 + ch * 8);
            *(LAS u32x4*)(Vst + rho * 144 + ch * 16) = w; }
        float s[8]; float mx = -INFINITY;
#pragma unroll
        for (int hf = 0; hf < 2; ++hf)
#pragma unroll
            for (int ii = 0; ii < 4; ++ii) { const int v = 32 * ks + 8 * g + 4 * hf + ii; const int t = l16; int cnt = 0;
                if (t < 4) { if (v < 896) { const int p = samp_pos(v); cnt = (p >= 1920 + t ? 1 : 0) + ((p >= 1536 && (p & 3) == t) ? 1 : 0) + ((p & 15) == t ? 1 : 0); }
                             else if (v < 900) { const int tp = v - 896; cnt = (tp <= t ? 1 : 0) + (tp == t ? 2 : 0); } }
                const float lg = cnt == 3 ? 1.5849625007211562f : (cnt == 2 ? 1.f : 0.f);
                const float sv = cnt > 0 ? S[hf][ii] * ATT_SCL + lg : -INFINITY; s[hf * 4 + ii] = sv; mx = fmaxf(mx, sv); }
        mx = xmax4(mx);
        const float mn = fmaxf(m_run, mx); const float alpha = ex2(m_run - mn); m_run = mn;
        float ps = 0.f;
#pragma unroll
        for (int i = 0; i < 8; ++i) { s[i] = ex2(s[i] - mn); ps += s[i]; }
        l_run = l_run * alpha + ps;
#pragma unroll
        for (int dt = 0; dt < 4; ++dt) O[dt] = O[dt] * alpha;
        u32x4 pw; pw.x = pk2(s[0], s[1]); pw.y = pk2(s[2], s[3]); pw.z = pk2(s[4], s[5]); pw.w = pk2(s[6], s[7]);
        const bf16x8 pf = asfrag(pw);
#pragma unroll
        for (int dt = 0; dt < 4; ++dt) { const bf16x8 vf = tr_frag(Vst, 144, 0, 16 * dt, lane); O[dt] = MFMA16(vf, pf, O[dt]); }
    }
    const float lt = xsum4(l_run);
    if (l16 < 4) { const float inv = 1.f / lt; bf16* op = MIX + (srow + l16) * DM + 512 + h * 64 + 4 * g;
#pragma unroll
        for (int dt = 0; dt < 4; ++dt) { u32x2 w; w.x = pk2(O[dt][0] * inv, O[dt][1] * inv); w.y = pk2(O[dt][2] * inv, O[dt][3] * inv); *(u32x2*)(op + 16 * dt) = w; } }
}

__device__ __forceinline__ void ph3_mlstm_sample_unit(const Params& P, const Ctx& C, int u) {
    unsigned char* ws = P.ws; const int tid = C.tid, lane = C.lane, wave = C.wave;
    const int db = u >> 2, h = u & 3; const size_t srow = (size_t)MP + db * 4;
    const bf16* Z = (const bf16*)(ws + WS_Z); bf16* MIX = (bf16*)(ws + WS_MIX); const float* GI = (const float*)(ws + WS_GI); const float* GF = (const float*)(ws + WS_GF);
    LAS float* qk = (LAS float*)C.W;
    LAS float* vv = qk + 1024;
    LAS float* pn = vv + 512;
    LAS float* pd = pn + 512;
    LAS float* hb = pd + 16;
    if (tid < 256) { const int ch = tid < 128 ? h * 128 + tid : 512 + h * 128 + (tid - 128);
        float up[7];
#pragma unroll
        for (int j = 0; j < 3; ++j) up[j] = P.st_conv[((size_t)db * 3 + j) * 1024 + ch];
#pragma unroll
        for (int t = 0; t < 4; ++t) up[3 + t] = bf2f(Z[(srow + t) * NZ + ch]);
        const float cb = P.conv_b[ch]; float cw[4];
#pragma unroll
        for (int j = 0; j < 4; ++j) cw[j] = P.conv_w[j * 1024 + ch];
#pragma unroll
        for (int t = 0; t < 4; ++t) { float a = cb;
#pragma unroll
            for (int j = 0; j < 4; ++j) a += cw[j] * up[t + j];
            a = a * __builtin_amdgcn_rcpf(1.f + fexp(-a)); if (tid >= 128) a *= 0.08838834764831845f; qk[t * 256 + tid] = a; } }
    else if (tid < 384) { const int e = tid - 256;
#pragma unroll
        for (int t = 0; t < 4; ++t) vv[t * 128 + e] = bf2f(Z[(srow + t) * NZ + ZV + h * 128 + e]); }
    const int e = tid & 127, dq = tid >> 7;
    float Cr[32], nr[32];
    { const float* cp = P.st_C + ((size_t)(db * 4 + h) * 128 + dq * 32) * 128 + e; const float* np = P.st_n + (size_t)(db * 4 + h) * 128 + dq * 32;
#pragma unroll
      for (int r = 0; r < 32; ++r) { Cr[r] = cp[(size_t)r * 128]; nr[r] = np[r]; } }
    float m = P.st_m[db * 4 + h];
    __syncthreads();
#pragma unroll 1
    for (int t = 0; t < 4; ++t) {
        const float ig = GI[(srow + t) * 4 + h], lf = GF[(srow + t) * 4 + h];
        const float mn = fmaxf(lf + m, ig); const float fw = fexp(lf + m - mn), iw = fexp(ig - mn); m = mn;
        const float ve = vv[t * 128 + e]; float num = 0.f, den = 0.f;
#pragma unroll
        for (int r = 0; r < 32; ++r) { const float kd = qk[t * 256 + 128 + dq * 32 + r], qd = qk[t * 256 + dq * 32 + r];
            Cr[r] = fw * Cr[r] + iw * kd * ve; nr[r] = fw * nr[r] + iw * kd; num += qd * Cr[r]; den += qd * nr[r]; }
        pn[dq * 128 + e] = num; if (e == 0) pd[dq] = den;
        __syncthreads();
        if (tid < 128) { const float nm = (pn[tid] + pn[128 + tid]) + (pn[256 + tid] + pn[384 + tid]); const float dn = (pd[0] + pd[1]) + (pd[2] + pd[3]);
            hb[tid] = nm / fmaxf(fabsf(dn), fexp(-m)); }
        __syncthreads();
        if (wave == 0) { const float h0 = hb[lane], h1 = hb[64 + lane]; const float mean = wave_sum(h0 + h1) * (1.f / 128.f); const float d0 = h0 - mean, d1 = h1 - mean;
            const float var = wave_sum(d0 * d0 + d1 * d1) * (1.f / 128.f); const float rstd = 1.0f / sqrtf(var + EPS);
            const float o0 = bf2f(Z[(srow + t) * NZ + ZO + h * 128 + lane]), o1 = bf2f(Z[(srow + t) * NZ + ZO + h * 128 + 64 + lane]);
            const float y0 = d0 * rstd * P.g_mh[h * 128 + lane] * __builtin_amdgcn_rcpf(1.f + fexp(-o0)), y1 = d1 * rstd * P.g_mh[h * 128 + 64 + lane] * __builtin_amdgcn_rcpf(1.f + fexp(-o1));
            MIX[(srow + t) * DM + h * 128 + lane] = (bf16)(pk2(y0, 0.f) & 0xffffu); MIX[(srow + t) * DM + h * 128 + 64 + lane] = (bf16)(pk2(y1, 0.f) & 0xffffu); }
        __syncthreads();
    }
    { float* co = P.out + O_SC + ((size_t)(db * 4 + h) * 128 + dq * 32) * 128 + e;
#pragma unroll
      for (int r = 0; r < 32; ++r) co[(size_t)r * 128] = Cr[r];
      if (e == 0) { float* no = P.out + O_SN + (size_t)(db * 4 + h) * 128 + dq * 32;
#pragma unroll
          for (int r = 0; r < 32; ++r) no[r] = nr[r]; }
      if (tid == 0) P.out[O_SM + db * 4 + h] = m; }
    __syncthreads();
}

__device__ __forceinline__ void ph4_mlstm_out(const Params& P, const Ctx& C) {
    unsigned char* ws = P.ws; const int tid = C.tid, lane = C.lane, wave = C.wave; const int g = lane >> 4, l16 = lane & 15;
    constexpr int RB = 272;
    const bf16* Z = (const bf16*)(ws + WS_Z); const float* GI = (const float*)(ws + WS_GI); const float* GF = (const float*)(ws + WS_GF);
    const bf16* QC = (const bf16*)(ws + WS_QC); const bf16* KC = (const bf16*)(ws + WS_KC); const bf16* CS = (const bf16*)(ws + WS_CS); const float* NS = (const float*)(ws + WS_NS);
    const float* MST = (const float*)(ws + WS_MST); bf16* MIX = (bf16*)(ws + WS_MIX);
    LAS unsigned char* VI = C.W + (wave >> 2) * 64 * RB;
    LAS float* sc = (LAS float*)(C.W + 2 * 64 * RB) + wave * 256;
    for (int u = C.vcu; u < 8 * (NCH / 2); u += C.G) {
        const int bh = u >> 6, cp = u & 63, b = bh >> 2, h = bh & 3;
        { const int ci = tid >> 8, r = (tid & 255) >> 2, qd = tid & 3; const bf16* src = Z + (size_t)(b * SEQ + (2 * cp + ci) * 64 + r) * NZ + ZV + h * 128 + qd * 32;
          LAS unsigned char* dst = C.W + ci * 64 * RB + r * RB + qd * 64;
#pragma unroll
          for (int i = 0; i < 4; ++i) *(LAS u32x4*)(dst + 16 * i) = *(const u32x4*)(src + 8 * i); }
        const int c = 2 * cp + (wave >> 2), T = wave & 3; const int row0 = b * SEQ + c * 64;
        { const float ig = GI[(size_t)(row0 + lane) * 4 + h], lf = GF[(size_t)(row0 + lane) * 4 + h];
          const float bs = wave_scan_sum(lf, lane); const float us = ig - bs; const float pm = wave_scan_max(us, lane); const float ms = MST[bh * NCH + c];
          const float mt = bs + fmaxf(ms, pm);
          sc[lane] = bs - mt; sc[64 + lane] = fexp(bs + ms - mt); sc[128 + lane] = fexp(-mt); sc[192 + lane] = us; }
        __syncthreads();
        const int t = 16 * T + l16;
        const float bm_t = sc[t], wa_t = sc[64 + t], em_t = sc[128 + t];
        bf16x8 qf[4];
        { const bf16* qp = QC + (size_t)(row0 + t) * 512 + h * 128 + 8 * g;
#pragma unroll
          for (int kk = 0; kk < 4; ++kk) qf[kk] = *(const bf16x8*)(qp + 32 * kk); }
        f32x4 acc[8];
        { const bf16* cb = CS + (size_t)(bh * NCH + c) * 16384 + (size_t)l16 * 128 + 8 * g;
#pragma unroll
          for (int et = 0; et < 8; ++et) { acc[et] = (f32x4){0.f, 0.f, 0.f, 0.f};
#pragma unroll
              for (int kk = 0; kk < 4; ++kk) { const bf16x8 cf = *(const bf16x8*)(cb + (size_t)et * 16 * 128 + 32 * kk); acc[et] = MFMA16(cf, qf[kk], acc[et]); }
              acc[et] = acc[et] * wa_t; } }
        float den;
        { const float* np = NS + (size_t)(bh * NCH + c) * 128 + 8 * g; float qn = 0.f;
#pragma unroll
          for (int kk = 0; kk < 4; ++kk) { const f32x4 n0 = *(const f32x4*)(np + 32 * kk), n1 = *(const f32x4*)(np + 32 * kk + 4); const u32x4 qw = __builtin_bit_cast(u32x4, qf[kk]);
              qn += (bflo(qw.x) * n0[0] + bfhi(qw.x) * n0[1]) + (bflo(qw.y) * n0[2] + bfhi(qw.y) * n0[3]) + (bflo(qw.z) * n1[0] + bfhi(qw.z) * n1[1]) + (bflo(qw.w) * n1[2] + bfhi(qw.w) * n1[3]); }
          den = wa_t * xsum4(qn); }
        float rsum = 0.f;
        for (int p = 0; p <= (T >> 1); ++p) {
            float w[8];
#pragma unroll
            for (int hf = 0; hf < 2; ++hf) { const int s_a = 32 * p + 8 * (l16 >> 2) + 4 * hf + (l16 & 3);
                const bf16* kp = KC + (size_t)(row0 + s_a) * 512 + h * 128 + 8 * g; f32x4 S = {0.f, 0.f, 0.f, 0.f};
#pragma unroll
                for (int kk = 0; kk < 4; ++kk) S = MFMA16(*(const bf16x8*)(kp + 32 * kk), qf[kk], S);
                const f32x4 us4 = *(const LAS f32x4*)(sc + 192 + 32 * p + 8 * g + 4 * hf);
#pragma unroll
                for (int ii = 0; ii < 4; ++ii) { const int s_d = 32 * p + 8 * g + 4 * hf + ii; const float wv = (s_d <= t) ? S[ii] * fexp(bm_t + us4[ii]) : 0.f; w[hf * 4 + ii] = wv; rsum += wv; } }
            u32x4 pw; pw.x = pk2(w[0], w[1]); pw.y = pk2(w[2], w[3]); pw.z = pk2(w[4], w[5]); pw.w = pk2(w[6], w[7]);
            const bf16x8 pf = asfrag(pw);
#pragma unroll
            for (int et = 0; et < 8; ++et) { const bf16x8 vf = tr_frag(VI, RB, 32 * p, 16 * et, lane); acc[et] = MFMA16(vf, pf, acc[et]); }
        }
        den += xsum4(rsum);
        const float inv = 1.f / fmaxf(fabsf(den), em_t);
        float sm = 0.f;
#pragma unroll
        for (int et = 0; et < 8; ++et) { acc[et] = acc[et] * inv; sm += (acc[et][0] + acc[et][1]) + (acc[et][2] + acc[et][3]); }
        const float mean = xsum4(sm) * (1.f / 128.f); float sq = 0.f;
#pragma unroll
        for (int et = 0; et < 8; ++et) { acc[et] = acc[et] - mean; sq += (acc[et][0] * acc[et][0] + acc[et][1] * acc[et][1]) + (acc[et][2] * acc[et][2] + acc[et][3] * acc[et][3]); }
        const float rstd = 1.0f / sqrtf(xsum4(sq) * (1.f / 128.f) + EPS);
        { const bf16* op = Z + (size_t)(row0 + t) * NZ + ZO + h * 128 + 4 * g; bf16* mp = MIX + (size_t)(row0 + t) * DM + h * 128 + 4 * g; const float* gp = P.g_mh + h * 128 + 4 * g;
#pragma unroll
          for (int et = 0; et < 8; ++et) { const u32x2 ow = *(const u32x2*)(op + 16 * et); const f32x4 gm = *(const f32x4*)(gp + 16 * et);
              const float y0 = acc[et][0] * rstd * gm[0] * __builtin_amdgcn_rcpf(1.f + fexp(-bflo(ow.x))), y1 = acc[et][1] * rstd * gm[1] * __builtin_amdgcn_rcpf(1.f + fexp(-bfhi(ow.x)));
              const float y2 = acc[et][2] * rstd * gm[2] * __builtin_amdgcn_rcpf(1.f + fexp(-bflo(ow.y))), y3 = acc[et][3] * rstd * gm[3] * __builtin_amdgcn_rcpf(1.f + fexp(-bfhi(ow.y)));
              u32x2 w2; w2.x = pk2(y0, y1); w2.y = pk2(y2, y3); *(u32x2*)(mp + 16 * et) = w2; } }
        __syncthreads();
    }
}

__device__ __forceinline__ void ph7_xattn_prompt_unit(const Params& P, const Ctx& C, int u) {
    unsigned char* ws = P.ws; const int tid = C.tid, lane = C.lane, wave = C.wave; const int g = lane >> 4, l16 = lane & 15;
    constexpr int RB = 528;
    const int b = u >> 7, h = (u >> 5) & 3, qb = u & 31;
    const bf16* QX = (const bf16*)(ws + WS_QX); const bf16* MK = (const bf16*)(ws + WS_MEMK); const bf16* MV = (const bf16*)(ws + WS_MEMV); bf16* OX = (bf16*)(ws + WS_OX);
    LAS unsigned char* VI = C.W;
    { const int r = tid >> 1, hv = tid & 1; const bf16* src = MV + (size_t)(b * 256 + r) * 1024 + h * 256 + hv * 128; LAS unsigned char* dst = VI + r * RB + hv * 256;
#pragma unroll
      for (int i = 0; i < 16; ++i) *(LAS u32x4*)(dst + 16 * i) = *(const u32x4*)(src + 8 * i); }
    __syncthreads();
    const size_t qrow = (size_t)b * SEQ + qb * 256 + wave * 32;
    bf16x8 qf[2][8];
#pragma unroll
    for (int qt = 0; qt < 2; ++qt) { const bf16* qp = QX + (qrow + qt * 16 + l16) * DM + h * 256 + 8 * g;
#pragma unroll
        for (int kk = 0; kk < 8; ++kk) qf[qt][kk] = *(const bf16x8*)(qp + 32 * kk); }
    f32x4 O[2][16]; float m_run[2], l_run[2];
#pragma unroll
    for (int qt = 0; qt < 2; ++qt) { m_run[qt] = -1e30f; l_run[qt] = 0.f;
#pragma unroll
        for (int dt = 0; dt < 16; ++dt) O[qt][dt] = (f32x4){0.f, 0.f, 0.f, 0.f}; }
    const bf16* kbase = MK + (size_t)(b * 256) * 1024 + h * 256 + 8 * g;
    for (int ks = 0; ks < 8; ++ks) {
        f32x4 S[2][2];
#pragma unroll
        for (int hf = 0; hf < 2; ++hf)
#pragma unroll
            for (int qt = 0; qt < 2; ++qt) S[hf][qt] = (f32x4){0.f, 0.f, 0.f, 0.f};
#pragma unroll
        for (int kk = 0; kk < 8; ++kk)
#pragma unroll
            for (int hf = 0; hf < 2; ++hf) { const int key = 32 * ks + 8 * (l16 >> 2) + 4 * hf + (l16 & 3); const bf16x8 kf = *(const bf16x8*)(kbase + (size_t)key * 1024 + 32 * kk);
#pragma unroll
                for (int qt = 0; qt < 2; ++qt) S[hf][qt] = MFMA16(kf, qf[qt][kk], S[hf][qt]); }
        bf16x8 pf[2];
#pragma unroll
        for (int qt = 0; qt < 2; ++qt) { float mx = fmaxf(fmaxf(fmaxf(S[0][qt][0], S[0][qt][1]), fmaxf(S[0][qt][2], S[0][qt][3])), fmaxf(fmaxf(S[1][qt][0], S[1][qt][1]), fmaxf(S[1][qt][2], S[1][qt][3])));
            mx = xmax4(mx); const float mn = fmaxf(m_run[qt], mx); const float alpha = ex2(m_run[qt] - mn); m_run[qt] = mn;
            float s[8]; float ps = 0.f;
#pragma unroll
            for (int i = 0; i < 4; ++i) { s[i] = ex2(S[0][qt][i] - mn); s[4 + i] = ex2(S[1][qt][i] - mn); ps += s[i] + s[4 + i]; }
            l_run[qt] = l_run[qt] * alpha + ps;
#pragma unroll
            for (int dt = 0; dt < 16; ++dt) O[qt][dt] = O[qt][dt] * alpha;
            u32x4 pw; pw.x = pk2(s[0], s[1]); pw.y = pk2(s[2], s[3]); pw.z = pk2(s[4], s[5]); pw.w = pk2(s[6], s[7]); pf[qt] = asfrag(pw); }
#pragma unroll
        for (int dt = 0; dt < 16; ++dt) { const bf16x8 vf = tr_frag(VI, RB, 32 * ks, 16 * dt, lane);
#pragma unroll
            for (int qt = 0; qt < 2; ++qt) O[qt][dt] = MFMA16(vf, pf[qt], O[qt][dt]); }
    }
#pragma unroll
    for (int qt = 0; qt < 2; ++qt) { const float inv = 1.f / xsum4(l_run[qt]); bf16* op = OX + (qrow + qt * 16 + l16) * DM + h * 256 + 4 * g;
#pragma unroll
        for (int dt = 0; dt < 16; ++dt) { u32x2 w; w.x = pk2(O[qt][dt][0] * inv, O[qt][dt][1] * inv); w.y = pk2(O[qt][dt][2] * inv, O[qt][dt][3] * inv); *(u32x2*)(op + 16 * dt) = w; } }
    __syncthreads();
}
__device__ __forceinline__ void ph7_xattn_sample_unit(const Params& P, const Ctx& C, int u) {
    unsigned char* ws = P.ws; const int tid = C.tid, lane = C.lane, wave = C.wave; const int g = lane >> 4, l16 = lane & 15; const int tq = l16 < 3 ? l16 : 3;
    const int db = u >> 1, hp = u & 1; const int head = hp * 2 + (wave >> 2), kq = wave & 3; const size_t srow = (size_t)MP + db * 4;
    const bf16* QX = (const bf16*)(ws + WS_QX); bf16* OX = (bf16*)(ws + WS_OX);
    LAS float* Pl = (LAS float*)C.W + wave * 256;
    LAS float* Mg = (LAS float*)(C.W + 8192);
    LAS float* Lg = Mg + 32;
    LAS float* Og = (LAS float*)(C.W + 8192 + 256);
    bf16x8 qf[8];
    { const bf16* qp = QX + (srow + tq) * DM + head * 256 + 8 * g;
#pragma unroll
      for (int kk = 0; kk < 8; ++kk) qf[kk] = *(const bf16x8*)(qp + 32 * kk); }
    const float* kb = P.cmem_k + ((size_t)(db * 256 + kq * 64) * 4 + head) * 256; const float* vb = P.cmem_v + ((size_t)(db * 256 + kq * 64) * 4 + head) * 256;
    f32x4 S[2][2];
#pragma unroll
    for (int ks = 0; ks < 2; ++ks)
#pragma unroll
        for (int hf = 0; hf < 2; ++hf) { const int key = 32 * ks + 8 * (l16 >> 2) + 4 * hf + (l16 & 3); const float* kp = kb + (size_t)key * 1024 + 8 * g; f32x4 a = {0.f, 0.f, 0.f, 0.f};
#pragma unroll
            for (int kk = 0; kk < 8; ++kk) { const u32x4 kw = pk8(*(const f32x4*)(kp + 32 * kk), *(const f32x4*)(kp + 32 * kk + 4)); a = MFMA16(asfrag(kw), qf[kk], a); }
            S[ks][hf] = a; }
    float mx = -INFINITY;
#pragma unroll
    for (int ks = 0; ks < 2; ++ks)
#pragma unroll
        for (int hf = 0; hf < 2; ++hf)
#pragma unroll
            for (int ii = 0; ii < 4; ++ii) mx = fmaxf(mx, S[ks][hf][ii]);
    mx = xmax4(mx); float ps = 0.f;
#pragma unroll
    for (int ks = 0; ks < 2; ++ks)
#pragma unroll
        for (int hf = 0; hf < 2; ++hf)
#pragma unroll
            for (int ii = 0; ii < 4; ++ii) { const float pv = ex2(S[ks][hf][ii] - mx); ps += pv; if (l16 < 4) Pl[(32 * ks + 8 * g + 4 * hf + ii) * 4 + l16] = pv; }
    ps = xsum4(ps);
    if (lane < 4) { Mg[wave * 4 + lane] = mx; Lg[wave * 4 + lane] = ps; }
    LDS_WAIT(); asm volatile("" ::: "memory");
    f32x4 o0 = {0.f, 0.f, 0.f, 0.f}, o1 = o0, o2 = o0, o3 = o0;
#pragma unroll 8
    for (int key = 0; key < 64; ++key) { const f32x4 v4 = *(const f32x4*)(vb + (size_t)key * 1024 + 4 * lane); const f32x4 p4 = *(const LAS f32x4*)(Pl + key * 4);
        o0 += v4 * p4[0]; o1 += v4 * p4[1]; o2 += v4 * p4[2]; o3 += v4 * p4[3]; }
    { LAS float* og = Og + wave * 1024 + 4 * lane; *(LAS f32x4*)og = o0; *(LAS f32x4*)(og + 256) = o1; *(LAS f32x4*)(og + 512) = o2; *(LAS f32x4*)(og + 768) = o3; }
    __syncthreads();
    { const int hd = tid >> 8, t = (tid >> 6) & 3, d4 = (tid & 63) * 4; const int w0 = hd * 4;
      const float m0 = Mg[(w0 + 0) * 4 + t], m1 = Mg[(w0 + 1) * 4 + t], m2 = Mg[(w0 + 2) * 4 + t], m3 = Mg[(w0 + 3) * 4 + t]; const float mm = fmaxf(fmaxf(m0, m1), fmaxf(m2, m3));
      const float f0 = ex2(m0 - mm), f1 = ex2(m1 - mm), f2 = ex2(m2 - mm), f3 = ex2(m3 - mm);
      const float lt = (f0 * Lg[(w0 + 0) * 4 + t] + f1 * Lg[(w0 + 1) * 4 + t]) + (f2 * Lg[(w0 + 2) * 4 + t] + f3 * Lg[(w0 + 3) * 4 + t]);
      const f32x4 a0 = *(const LAS f32x4*)(Og + (w0 + 0) * 1024 + t * 256 + d4), a1 = *(const LAS f32x4*)(Og + (w0 + 1) * 1024 + t * 256 + d4), a2 = *(const LAS f32x4*)(Og + (w0 + 2) * 1024 + t * 256 + d4), a3 = *(const LAS f32x4*)(Og + (w0 + 3) * 1024 + t * 256 + d4);
      const f32x4 o = ((a0 * f0 + a1 * f1) + (a2 * f2 + a3 * f3)) * (1.f / lt);
      u32x2 w; w.x = pk2(o[0], o[1]); w.y = pk2(o[2], o[3]); *(u32x2*)(OX + (srow + t) * DM + (hp * 2 + hd) * 256 + d4) = w; }
    __syncthreads();
}

__device__ __forceinline__ void ph11_final(const Params& P, const Ctx& C) {
    const float* X3 = (const float*)(P.ws + WS_X3); const float* SS3 = (const float*)(P.ws + WS_SS) + 2 * MROWS; const int lane = C.lane;
    const int gw = C.vcu * 8 + C.wave, NGW = C.G * 8;
    f32x4 gv[4];
#pragma unroll
    for (int j = 0; j < 4; ++j) gv[j] = ((const f32x4*)P.g_final)[lane + 64 * j];
    for (int m = gw; m < MROWS; m += NGW) { const float rs = 1.0f / sqrtf(SS3[m] * (1.f / DM) + EPS); const f32x4* xr = (const f32x4*)(X3 + (size_t)m * DM); f32x4* yr = (f32x4*)(P.out + O_Y + (size_t)m * DM);
#pragma unroll
        for (int j = 0; j < 4; ++j) yr[lane + 64 * j] = xr[lane + 64 * j] * rs * gv[j]; }
}
#define XB_TMO      128
#define XB_XCNT(j)  (256  + 64 * (j))
#define XB_XSUB(j)  (1280 + 64 * (j))
#define XB_XGEN(j)  (2304 + 64 * (j))
#define XB_TOP      3328
#define XB_TOPGEN   3392
#define XCD_BAR_WORDS 3456
#define XB_SPIN_CAP (1u << 18)

__device__ __forceinline__ unsigned xb_ld(unsigned* p)              { return __hip_atomic_load(p, __ATOMIC_RELAXED, __HIP_MEMORY_SCOPE_AGENT); }
__device__ __forceinline__ unsigned xb_add(unsigned* p, unsigned v) { return __hip_atomic_fetch_add(p, v, __ATOMIC_RELAXED, __HIP_MEMORY_SCOPE_AGENT); }
__device__ __forceinline__ unsigned xb_xcc_id() { return (unsigned)__builtin_amdgcn_s_getreg((3 << 11) | 20) & 0xFu; }
#define XB_SPIN(cond, bar) do { unsigned _sp = 0; while (cond) { __builtin_amdgcn_s_sleep(1); \
    if ((++_sp & 255u) == 0u) { if (xb_ld(&(bar)[XB_TMO])) break; if (_sp > XB_SPIN_CAP) { atomicAdd(&(bar)[XB_TMO], 1u); break; } } } } while (0)

struct XcdBarrier {
    unsigned* bar; unsigned x;
    volatile LAS unsigned* st;
};

__device__ __forceinline__ XcdBarrier xcd_barrier_post(unsigned* bar, volatile LAS unsigned* st) {
    XcdBarrier b; b.bar = bar; b.x = xb_xcc_id(); b.st = st;
    if (threadIdx.x == 0) (void)xb_add(&bar[XB_XCNT(b.x)], 1u);
    return b;
}
__device__ __forceinline__ void xcd_barrier_complete(unsigned* bar, unsigned x, unsigned& nloc, unsigned& nx) {
    const unsigned G = gridDim.x * gridDim.y * gridDim.z;
    unsigned sum, cnt, mine, sp = 0u;
    for (;;) {
        sum = 0u; cnt = 0u; mine = 0u;
#pragma unroll
        for (unsigned j = 0; j < 16; ++j) { const unsigned c = xb_ld(&bar[XB_XCNT(j)]); sum += c; cnt += (c > 0u) ? 1u : 0u; mine = (j == x) ? c : mine; }
        if (sum == G) break;
        __builtin_amdgcn_s_sleep(1);
        if ((++sp & 255u) == 0u) { if (xb_ld(&bar[XB_TMO])) break; if (sp > XB_SPIN_CAP) { atomicAdd(&bar[XB_TMO], 1u); break; } }
    }
    nloc = mine > 0u ? mine : 1u; nx = cnt > 0u ? cnt : 1u;
}

__device__ __forceinline__ void xcd_barrier(const XcdBarrier& b) {
    asm volatile("s_waitcnt vmcnt(0)" ::: "memory");
    __syncthreads();
    if (threadIdx.x == 0) {
        unsigned* bar = b.bar;
        __builtin_amdgcn_s_waitcnt(0);
        unsigned nloc = b.st[0], nx = b.st[1];
        if (nloc == 0u) { xcd_barrier_complete(bar, b.x, nloc, nx); b.st[0] = nloc; b.st[1] = nx; }
        const unsigned old = xb_add(&bar[XB_XSUB(b.x)], 1u);
        const unsigned gen = old / nloc;
        if (old + 1u == (gen + 1u) * nloc) {
            __builtin_amdgcn_fence(__ATOMIC_RELEASE, "agent");
            asm volatile("s_waitcnt vmcnt(0)" ::: "memory");
            const unsigned og = xb_add(&bar[XB_TOP], 1u);
            const unsigned tg = og / nx;
            if (og + 1u == (tg + 1u) * nx) xb_add(&bar[XB_TOPGEN], 1u);
            else XB_SPIN(xb_ld(&bar[XB_TOPGEN]) == tg, bar);
            __builtin_amdgcn_fence(__ATOMIC_ACQUIRE, "agent");
            xb_add(&bar[XB_XGEN(b.x)], 1u);
            asm volatile("s_waitcnt vmcnt(0)" ::: "memory");
        } else {
            XB_SPIN(xb_ld(&bar[XB_XGEN(b.x)]) == gen, bar);
            __builtin_amdgcn_fence(__ATOMIC_ACQUIRE, "agent");
            asm volatile("s_waitcnt vmcnt(0)" ::: "memory");
        }
    }
    __syncthreads();
}
constexpr int NPH = 12;
constexpr int N_LAUNCHES = MK_N_LAUNCHES;
constexpr int LDS_BYTES = 147456, LDS_WORK_OFF = 1024;
__global__ void __launch_bounds__(512, 2) hymba_fwd(Params P) {
    extern __shared__ __attribute__((aligned(16))) unsigned char lds_raw[];
    LAS unsigned char* lds = (LAS unsigned char*)lds_raw;
    Ctx C; C.tid = threadIdx.x; C.lane = C.tid & 63; C.wave = __builtin_amdgcn_readfirstlane(C.tid >> 6);
    C.G = gridDim.x; { const int bx = blockIdx.x; C.vcu = (C.G % 8 == 0) ? (bx % 8) * (C.G / 8) + bx / 8 : bx; }
    C.W = lds + LDS_WORK_OFF;
    for (int i = C.tid; i < LDS_WORK_OFF / 4; i += 512) ((LAS unsigned*)lds)[i] = 0u;
    __syncthreads();
    unsigned char* ws = P.ws;
    unsigned* barw = (unsigned*)(ws + WS_CTL) + CW_BAR;
    XcdBarrier bar; bar.bar = barw; bar.x = 0; bar.st = nullptr;
    if (N_LAUNCHES == 1) bar = xcd_barrier_post(barw, (volatile LAS unsigned*)(lds + 64));
    const int lo = P.ph_lo, hi = P.ph_hi;
#define IN(k) (lo <= (k) && (k) < hi)
#define SEAM(k) do { if (IN(k) && IN((k) + 1)) xcd_barrier(bar); } while (0)
    bf16* XN = (bf16*)(ws + WS_XN); bf16* Zb = (bf16*)(ws + WS_Z); bf16* MIX = (bf16*)(ws + WS_MIX);
    float* SS1 = (float*)(ws + WS_SS); float* SS2 = SS1 + MROWS; float* SS3 = SS2 + MROWS;
    float* X1 = (float*)(ws + WS_X1); bf16* X1B = (bf16*)(ws + WS_X1B); float* X2 = (float*)(ws + WS_X2); bf16* X2B = (bf16*)(ws + WS_X2B); float* X3 = (float*)(ws + WS_X3);

    if (IN(0)) { ph0_prologue(P, C); } SEAM(0);
    if (IN(1)) {
        { pg8::Gemm g{XN, (const bf16*)(ws + WS_WIN), MROWS, NZ, DM}; pg8::StaticOrder S; S.init(MROWS, NZ, C.G, (int)blockIdx.x); pg8::EpiIn E{Zb, P.out};
          pg8::gemm_phase<pg8::EpiIn, pg8::StaticOrder, true, true>(C.W, g, S, E); }
        { pg8::Gemm g{(const bf16*)(ws + WS_MN), (const bf16*)(ws + WS_WMKV), 512, 2048, DM}; pg8::StaticOrder S; S.init(512, 2048, C.G, C.G - 1 - (int)blockIdx.x);
          pg8::EpiMem E{(bf16*)(ws + WS_MEMK), (bf16*)(ws + WS_MEMV), P.out};
          pg8::gemm_phase<pg8::EpiMem, pg8::StaticOrder, true, true>(C.W, g, S, E); }
    } SEAM(1);
    if (IN(2)) { ph2_mlstm_local(P, C); } SEAM(2);
    if (IN(3)) {
        for (int u = C.vcu; u < 258; u += C.G) ph3_scan_unit(P, C, u);
        __syncthreads();
        for (int u = C.vcu; u < 512; u += C.G) ph3_attn_prompt_unit(P, C, u);
        for (int u = C.vcu; u < 512; u += C.G) ph3_mlstm_sample_unit(P, C, u);
        for (int u = C.vcu; u < DBATCH; u += C.G) ph3_attn_sample_unit(P, C, u);
    } SEAM(3);
    if (IN(4)) { ph4_mlstm_out(P, C); } SEAM(4);
    if (IN(5)) { pg8::Gemm g{MIX, (const bf16*)(ws + WS_WOUT), MROWS, DM, DM}; pg8::StaticOrder S; S.init(MROWS, DM, C.G, (int)blockIdx.x); pg8::EpiRes E{P.x_prompt, P.x_sample, X1, X1B, SS1};
        pg8::gemm_phase<pg8::EpiRes, pg8::StaticOrder, true, true>(C.W, g, S, E); } SEAM(5);
    if (IN(6)) { pg8::Gemm g{X1B, (const bf16*)(ws + WS_WMQ), MROWS, DM, DM}; pg8::StaticOrder S; S.init(MROWS, DM, C.G, (int)blockIdx.x); pg8::EpiQ E{(bf16*)(ws + WS_QX), SS1, 0.0625f * LOG2E};
        pg8::gemm_phase<pg8::EpiQ, pg8::StaticOrder, true, true>(C.W, g, S, E); } SEAM(6);
    if (IN(7)) {
        for (int u = C.vcu; u < 256; u += C.G) ph7_xattn_prompt_unit(P, C, u);
        for (int u = C.vcu; u < 256; u += C.G) ph7_xattn_sample_unit(P, C, u);
    } SEAM(7);
    if (IN(8)) { pg8::Gemm g{(const bf16*)(ws + WS_OX), (const bf16*)(ws + WS_WMO), MROWS, DM, DM}; pg8::StaticOrder S; S.init(MROWS, DM, C.G, (int)blockIdx.x); pg8::EpiRes E{X1, X1 + (size_t)MP * DM, X2, X2B, SS2};
        pg8::gemm_phase<pg8::EpiRes, pg8::StaticOrder, true, true>(C.W, g, S, E); } SEAM(8);
    if (IN(9)) { pg8::Gemm g{X2B, (const bf16*)(ws + WS_WGU), MROWS, NGU, DM}; pg8::StaticOrder S; S.init(MROWS, NGU, C.G, (int)blockIdx.x); pg8::EpiGU E{(bf16*)(ws + WS_H), SS2};
        pg8::gemm_phase<pg8::EpiGU, pg8::StaticOrder, true, true>(C.W, g, S, E); } SEAM(9);
    if (IN(10)) { pg8::Gemm g{(const bf16*)(ws + WS_H), (const bf16*)(ws + WS_WDN), MROWS, DM, FF}; pg8::StaticOrder S; S.init(MROWS, DM, C.G, (int)blockIdx.x); pg8::EpiRes E{X2, X2 + (size_t)MP * DM, X3, nullptr, SS3};
        pg8::gemm_phase<pg8::EpiRes, pg8::StaticOrder, true, true>(C.W, g, S, E); } SEAM(10);
    if (IN(11)) { ph11_final(P, C); }
#undef IN
#undef SEAM
}

extern "C" void kernel_launch(void* const* d_in, const int* in_sizes, int n_in, void* d_out, int out_size, void* d_ws, size_t ws_size, hipStream_t stream) {
    static int grid = 0;
    if (grid == 0) {
        if (n_in != 29 || (size_t)out_size != O_END || ws_size < WS_END) { fprintf(stderr, "kernel_launch: unexpected shapes: n_in %d out %d (want %zu) ws %zu (want >= %zu)\n", n_in, out_size, (size_t)O_END, ws_size, (size_t)WS_END); grid = -1; return; }
        int dev = 0, cus = 0, per_cu = 0;
        if (hipGetDevice(&dev) != hipSuccess || hipDeviceGetAttribute(&cus, hipDeviceAttributeMultiprocessorCount, dev) != hipSuccess) { grid = -1; return; }
        if (hipFuncSetAttribute((const void*)hymba_fwd, hipFuncAttributeMaxDynamicSharedMemorySize, LDS_BYTES) != hipSuccess) { fprintf(stderr, "kernel_launch: hipFuncSetAttribute failed\n"); grid = -1; return; }
        if (hipOccupancyMaxActiveBlocksPerMultiprocessor(&per_cu, (const void*)hymba_fwd, 512, LDS_BYTES) != hipSuccess || per_cu < 1) fprintf(stderr, "kernel_launch: occupancy query says %d\n", per_cu);
        (void)hipGetLastError();
        grid = cus;
    }
    if (grid < 0) return;
    (void)hipMemsetAsync((char*)d_ws + WS_CTL, 0, CTL_ZERO_BYTES, stream);
    Params p{};
    const float** pp = (const float**)&p;
    for (int i = 0; i < 29; ++i) pp[i] = (const float*)d_in[i];
    p.out = (float*)d_out; p.ws = (unsigned char*)d_ws; p.pad = 0;
    if (N_LAUNCHES == 1) { p.ph_lo = 0; p.ph_hi = NPH; p.li = 0; hipLaunchKernelGGL(hymba_fwd, dim3(grid), dim3(512), LDS_BYTES, stream, p); }
    else { for (int k = 0; k < NPH; ++k) { p.ph_lo = k; p.ph_hi = k + 1; p.li = k; hipLaunchKernelGGL(hymba_fwd, dim3(grid), dim3(512), LDS_BYTES, stream, p); } }
    const hipError_t le = hipPeekAtLastError();
    if (le != hipSuccess) fprintf(stderr, "kernel_launch: launch failed: %s\n", hipGetErrorName(le));
}
```

```cpp
#include <hip/hip_runtime.h>
#include <cstdio>
#include <cstdint>

#ifndef MK_N_LAUNCHES
#define MK_N_LAUNCHES 1
#endif

constexpr int DM = 1024, SEQ = 8192, NBATCH = 2, MP = NBATCH * SEQ, DBATCH = 128, DSEQ = 4, MSMP = DBATCH * DSEQ, MROWS = MP + MSMP;
constexpr int NZ = 3584, ZQ = 0, ZK = 512, ZV = 1024, ZO = 1536, ZQA = 2048, ZKA = 2560, ZVA = 3072;
constexpr int NIN = 3592, FF = 2816, NGU = 2 * FF, WB = 2048;
constexpr float EPS = 1e-6f;
constexpr int NCH = SEQ / 64;
constexpr size_t O_Y = 0, O_PATTK = (size_t)MROWS * DM, O_PATTV = O_PATTK + 2 * 2048 * 512, O_PCONV = O_PATTV + 2 * 2048 * 512, O_PC = O_PCONV + 2 * 3 * 1024,
                 O_PN = O_PC + 2 * 4 * 128 * 128, O_PM = O_PN + 2 * 4 * 128, O_PMEMK = O_PM + 8, O_PMEMV = O_PMEMK + 2 * 256 * 1024, O_SATTK = O_PMEMV + 2 * 256 * 1024,
                 O_SATTV = O_SATTK + (size_t)MSMP * 512, O_SCONV = O_SATTV + (size_t)MSMP * 512, O_SC = O_SCONV + (size_t)DBATCH * 3 * 1024, O_SN = O_SC + (size_t)DBATCH * 4 * 128 * 128,
                 O_SM = O_SN + (size_t)DBATCH * 4 * 128, O_END = O_SM + DBATCH * 4;
constexpr size_t MiB = 1u << 20;
constexpr size_t WS_CTL = 0, CTL_ZERO_BYTES = 1 * MiB;
constexpr size_t WS_WIN = 2 * MiB, WS_WOUT = 10 * MiB, WS_WMQ = 12 * MiB, WS_WMO = 14 * MiB, WS_WMKV = 16 * MiB, WS_WGU = 20 * MiB, WS_WDN = 32 * MiB;
constexpr size_t WS_GI = 39 * MiB, WS_GF = 39 * MiB + 512 * 1024, WS_SS = 40 * MiB;
constexpr size_t WS_LSUM = 41 * MiB, WS_MST = 41 * MiB + 64 * 1024, WS_NS = 41 * MiB + 512 * 1024;
constexpr size_t WS_MN = 42 * MiB, WS_MEMK = 43 * MiB, WS_MEMV = 44 * MiB;
constexpr size_t WS_XN = 48 * MiB, WS_Z = 82 * MiB, WS_QC = 198 * MiB, WS_KC = 214 * MiB, WS_DCX = 230 * MiB, WS_CS = 295 * MiB, WS_MIX = 328 * MiB;
constexpr size_t WS_X1 = 362 * MiB, WS_X1B = 428 * MiB, WS_QX = 462 * MiB, WS_OX = 496 * MiB, WS_X2 = 530 * MiB, WS_X2B = 596 * MiB, WS_H = 630 * MiB, WS_X3 = 722 * MiB, WS_QH = 788 * MiB, WS_KH = 804 * MiB, WS_VH = 820 * MiB, WS_END = 836 * MiB;
static_assert(WS_WIN + (size_t)NZ * DM * 2 <= WS_WOUT && WS_WGU + (size_t)NGU * DM * 2 <= WS_WDN && WS_WDN + (size_t)DM * FF * 2 <= WS_GI, "ws map: weights");
static_assert(WS_XN + (size_t)MROWS * DM * 2 <= WS_Z && WS_Z + (size_t)MROWS * NZ * 2 <= WS_QC && WS_DCX + (size_t)8 * NCH * 129 * 128 * 4 <= WS_CS && WS_CS + (size_t)8 * NCH * 16384 * 2 <= WS_MIX, "ws map: activations");
static_assert(WS_MIX + (size_t)MROWS * DM * 2 <= WS_X1 && WS_X1 + (size_t)MROWS * DM * 4 <= WS_X1B && WS_X1B + (size_t)MROWS * DM * 2 <= WS_QX && WS_H + (size_t)MROWS * FF * 2 <= WS_X3 && WS_X3 + (size_t)MROWS * DM * 4 <= WS_QH, "ws map: tail");
constexpr int CW_BAR = 4096;
namespace pg8 {
#define PG8_LAS __attribute__((address_space(3)))
typedef unsigned short bf16_t;
typedef short bf16x8 __attribute__((ext_vector_type(8)));
typedef float f32x4 __attribute__((ext_vector_type(4)));
typedef unsigned u32x4 __attribute__((ext_vector_type(4)));
constexpr int BM = 256, BK = 64, HALF = 128, HTB = HALF * BK * 2  , STAGE_BYTES = 8 * HTB, NXCD = 8, WGM = 8;

__host__ __device__ __forceinline__ int lds_byte(int r, int c) { const int st = (r >> 4) * 2 + (c >> 5), rr = r & 15, cc = c & 31, ob = rr * 64 + cc * 2; return st * 1024 + (ob ^ (((ob >> 9) & 1) << 5)); }
__host__ __device__ __forceinline__ void stage_rc(int b, int& R, int& C) { const int st = b / 1024, sb = b % 1024, swz = sb ^ (((sb >> 9) & 1) << 5); R = (st >> 1) * 16 + swz / 64; C = (st & 1) * 32 + (swz % 64) / 2; }
__host__ __device__ __forceinline__ int perm32(int rho) { const int n = rho >> 4, i = rho & 15; return 8 * (i >> 2) + 4 * n + (i & 3); }

struct Unit { int pm, pn; };
struct Gemm { const bf16_t* A; const bf16_t* Bt; int M, N, K; };

struct StaticOrder {
    int nM, nN, nwg, G, c;
    __host__ __device__ void init(int M, int N, int G_, int c_) { nM = M / BM; nN = N / BM; nwg = nM * nN; G = G_; c = c_; }
    __host__ __device__ bool next(int i, Unit& u) const {
        const long L = (long)i * G + c; if (L >= nwg) return false;
        int wgid = (int)L; { const int q = nwg / NXCD, r = nwg % NXCD, xcd = wgid % NXCD, off = wgid / NXCD; wgid = (xcd < r ? xcd * (q + 1) : r * (q + 1) + (xcd - r) * q) + off; }
        const int nig = WGM * nN, gid = wgid / nig, fm = gid * WGM, gsz = (nM - fm) < WGM ? (nM - fm) : WGM;
        u.pm = fm + ((wgid % nig) % gsz); u.pn = (wgid % nig) / gsz; return true;
    }
    __device__ __forceinline__ void a_ready(const Unit&) const {}
    __device__ __forceinline__ void done(const Unit&) const {}
};

__device__ __forceinline__ unsigned cvt_pk_bf16(float lo, float hi) { unsigned r; asm volatile("v_cvt_pk_bf16_f32 %0, %1, %2" : "=v"(r) : "v"(lo), "v"(hi)); return r; }
typedef float f32x2 __attribute__((ext_vector_type(2)));
typedef unsigned u32x2 __attribute__((ext_vector_type(2)));
__device__ __forceinline__ u32x4 pack8(const f32x4 v0, const f32x4 v1) { u32x4 w; w.x = cvt_pk_bf16(v0[0], v0[1]); w.y = cvt_pk_bf16(v0[2], v0[3]); w.z = cvt_pk_bf16(v1[0], v1[1]); w.w = cvt_pk_bf16(v1[2], v1[3]); return w; }
struct EpiIn {
    static constexpr bool PERM = true, AFTER_DRAIN = false;
    bf16_t* Z; float* out;
    __device__ __forceinline__ void operator()(const f32x4 (&acc)[2][2][4][2], const Unit& u, int wr, int wc, int fr, int fq) const {
        const int row0 = u.pm * BM + wr * 64 + fr, col0 = u.pn * BM + wc * 32 + 8 * fq;
        const bool conv_t = (u.pn < 4) && (u.pm == 31 || u.pm >= 63);
        const bool kv_t = (u.pn >= 10);
        const int isv = (u.pn >= 12) ? 1 : 0;
#pragma unroll
        for (int ai = 0; ai < 2; ++ai)
#pragma unroll
            for (int m = 0; m < 4; ++m) {
                const int row = row0 + ai * HALF + m * 16;
                bf16_t* rowp = Z + (size_t)row * NZ + col0;
                float* side = nullptr;
                if (conv_t) {
                    if (row < MP) { const int t = row & (SEQ - 1); if (t >= SEQ - 3) side = out + O_PCONV + (size_t)((row >> 13) * 3 + (t - (SEQ - 3))) * 1024 + col0; }
                    else { const int s = row - MP, t = s & 3; if (t >= 1) side = out + O_SCONV + (size_t)((s >> 2) * 3 + (t - 1)) * 1024 + col0; }
                } else if (kv_t) {
                    const int c = col0 - (isv ? ZVA : ZKA);
                    if (row < MP) { const int t = row & (SEQ - 1); if (t >= SEQ - 2048) side = out + (isv ? O_PATTV : O_PATTK) + (size_t)((row >> 13) * 2048 + (t - (SEQ - 2048))) * 512 + c; }
                    else side = out + (isv ? O_SATTV : O_SATTK) + (size_t)(row - MP) * 512 + c;
                }
#pragma unroll
                for (int bj = 0; bj < 2; ++bj) { const f32x4 v0 = acc[ai][bj][m][0], v1 = acc[ai][bj][m][1];
                    *(u32x4*)(rowp + bj * HALF) = pack8(v0, v1);
                    if (side) { *(f32x4*)(side + bj * HALF) = v0; *(f32x4*)(side + bj * HALF + 4) = v1; } }
            }
    }
};
struct EpiMem {
    static constexpr bool PERM = true, AFTER_DRAIN = false;
    bf16_t* MK; bf16_t* MV; float* out;
    __device__ __forceinline__ void operator()(const f32x4 (&acc)[2][2][4][2], const Unit& u, int wr, int wc, int fr, int fq) const {
        const int row0 = u.pm * BM + wr * 64 + fr, isv = (u.pn >= 4) ? 1 : 0, col0 = u.pn * BM + wc * 32 + 8 * fq - isv * 1024;
        bf16_t* B = isv ? MV : MK; float* O = out + (isv ? O_PMEMV : O_PMEMK);
#pragma unroll
        for (int ai = 0; ai < 2; ++ai)
#pragma unroll
            for (int m = 0; m < 4; ++m) { const size_t off = (size_t)(row0 + ai * HALF + m * 16) * 1024 + col0;
#pragma unroll
                for (int bj = 0; bj < 2; ++bj) { const f32x4 v0 = acc[ai][bj][m][0], v1 = acc[ai][bj][m][1];
                    *(u32x4*)(B + off + bj * HALF) = pack8(v0, v1); *(f32x4*)(O + off + bj * HALF) = v0; *(f32x4*)(O + off + bj * HALF + 4) = v1; } }
    }
};
struct EpiRes {
    static constexpr bool PERM = false, AFTER_DRAIN = false;
    const float* base0; const float* base1; float* X; bf16_t* Xb; float* SS;
    __device__ __forceinline__ void operator()(const f32x4 (&acc)[2][2][4][2], const Unit& u, int wr, int wc, int fr, int fq) const {
        const int row0 = u.pm * BM + wr * 64 + fr, col0 = u.pn * BM + wc * 32 + 4 * fq;
#pragma unroll
        for (int ai = 0; ai < 2; ++ai)
#pragma unroll
            for (int m = 0; m < 4; ++m) { const int row = row0 + ai * HALF + m * 16;
                const float* bp = (row < MP ? base0 + (size_t)row * 1024 : base1 + (size_t)(row - MP) * 1024) + col0;
                const size_t off = (size_t)row * 1024 + col0; float ssq = 0.f;
#pragma unroll
                for (int bj = 0; bj < 2; ++bj)
#pragma unroll
                    for (int n = 0; n < 2; ++n) { const int o = bj * HALF + n * 16; const f32x4 v = *(const f32x4*)(bp + o) + acc[ai][bj][m][n];
                        *(f32x4*)(X + off + o) = v;
                        if (Xb) { u32x2 w; w.x = cvt_pk_bf16(v[0], v[1]); w.y = cvt_pk_bf16(v[2], v[3]); *(u32x2*)(Xb + off + o) = w; }
                        ssq += (v[0] * v[0] + v[1] * v[1]) + (v[2] * v[2] + v[3] * v[3]); }
                ssq += __shfl_xor(ssq, 16); ssq += __shfl_xor(ssq, 32);
                if (fq == 0) unsafeAtomicAdd(SS + row, ssq); }
    }
};
struct EpiQ {
    static constexpr bool PERM = true, AFTER_DRAIN = false;
    bf16_t* Q; const float* SS; float scale;
    __device__ __forceinline__ void operator()(const f32x4 (&acc)[2][2][4][2], const Unit& u, int wr, int wc, int fr, int fq) const {
        const int row0 = u.pm * BM + wr * 64 + fr, col0 = u.pn * BM + wc * 32 + 8 * fq;
#pragma unroll
        for (int ai = 0; ai < 2; ++ai)
#pragma unroll
            for (int m = 0; m < 4; ++m) { const int row = row0 + ai * HALF + m * 16; const float rs = __builtin_amdgcn_rsqf(SS[row] * (1.f / 1024.f) + 1e-6f) * scale;
#pragma unroll
                for (int bj = 0; bj < 2; ++bj) *(u32x4*)(Q + (size_t)row * 1024 + col0 + bj * HALF) = pack8(acc[ai][bj][m][0] * rs, acc[ai][bj][m][1] * rs); }
    }
};
struct EpiGU {
    static constexpr bool PERM = true, AFTER_DRAIN = false;
    bf16_t* H; const float* SS;
    __device__ __forceinline__ f32x4 swi(const f32x4 g, const f32x4 uu) const { f32x4 r;
#pragma unroll
        for (int i = 0; i < 4; ++i) r[i] = g[i] * __builtin_amdgcn_rcpf(1.f + __builtin_amdgcn_exp2f(-1.4426950408889634f * g[i])) * uu[i];
        return r; }
    __device__ __forceinline__ void operator()(const f32x4 (&acc)[2][2][4][2], const Unit& u, int wr, int wc, int fr, int fq) const {
        const int row0 = u.pm * BM + wr * 64 + fr, col0 = u.pn * HALF + wc * 32 + 8 * fq;
#pragma unroll
        for (int ai = 0; ai < 2; ++ai)
#pragma unroll
            for (int m = 0; m < 4; ++m) { const int row = row0 + ai * HALF + m * 16; const float rs = __builtin_amdgcn_rsqf(SS[row] * (1.f / 1024.f) + 1e-6f);
                const f32x4 h0 = swi(acc[ai][0][m][0] * rs, acc[ai][1][m][0] * rs), h1 = swi(acc[ai][0][m][1] * rs, acc[ai][1][m][1] * rs);
                *(u32x4*)(H + (size_t)row * FF + col0) = pack8(h0, h1); }
    }
};
template <class Epi, class Sched, bool ALIGN_EPI = false, bool SP2 = false>
__device__ __forceinline__ void gemm_phase(PG8_LAS unsigned char* lds, const Gemm g, const Sched& S, const Epi& E) {
    const int tid = threadIdx.x, wid = __builtin_amdgcn_readfirstlane(tid >> 6), lane = tid & 63, wr = wid >> 2, wc = wid & 3, fr = lane & 15, fq = lane >> 4;
    const int K = g.K, nt = K / BK;
    unsigned voffA[2], voffB[2];
#pragma unroll
    for (int i = 0; i < 2; ++i) { int R, C; stage_rc(tid * 16 + i * 8192, R, C); const int Rb = Epi::PERM ? ((R & ~31) + perm32(R & 31)) : R;
        voffA[i] = (unsigned)(R * K + C) * 2u; voffB[i] = (unsigned)(Rb * K + C) * 2u; }
    const size_t kstep = (size_t)(BK * 2);
    const size_t hstep = (size_t)HALF * K * 2;
    const size_t tstep = 2 * hstep;
    const unsigned ldsw = (unsigned)wid * 1024u;
    const int aoff = lds_byte(wr * 64 + fr, fq * 8), boff = lds_byte(wc * 32 + fr, fq * 8);
#define PG8_SA(b, h) (((b) * 2 + (h)) * HTB)
#define PG8_SB(b, h) ((4 + (b) * 2 + (h)) * HTB)
#define PG8_STAGE(bufoff, gbase, voff) do { _Pragma("unroll") for (int _i = 0; _i < 2; ++_i) \
        __builtin_amdgcn_global_load_lds((const unsigned*)((const char*)(gbase) + (voff)[_i]), (PG8_LAS unsigned*)(lds + (bufoff) + ldsw + _i * 8192), 16, 0, 0); } while (0)
#define PG8_LDA(dst, b, h) do { _Pragma("unroll") for (int m = 0; m < 4; ++m) _Pragma("unroll") for (int k = 0; k < 2; ++k) dst[m][k] = *(const PG8_LAS bf16x8*)(lds + PG8_SA(b, h) + aoff + m * 2048 + k * 1024); } while (0)
#define PG8_LDB(dst, b, h) do { _Pragma("unroll") for (int n = 0; n < 2; ++n) _Pragma("unroll") for (int k = 0; k < 2; ++k) dst[n][k] = *(const PG8_LAS bf16x8*)(lds + PG8_SB(b, h) + boff + n * 2048 + k * 1024); } while (0)
#define PG8_MMA(ai, bj, At, Bt) do { __builtin_amdgcn_s_setprio(1); _Pragma("unroll") for (int m = 0; m < 4; ++m) _Pragma("unroll") for (int n = 0; n < 2; ++n) _Pragma("unroll") for (int k = 0; k < 2; ++k) \
        acc[ai][bj][m][n] = __builtin_amdgcn_mfma_f32_16x16x32_bf16(Bt[n][k], At[m][k], acc[ai][bj][m][n], 0, 0, 0); __builtin_amdgcn_s_setprio(0); } while (0)
#define PG8_WAIT_V(n) asm volatile("s_waitcnt vmcnt(" #n ")" ::: "memory")
#define PG8_WAIT_L(n) asm volatile("s_waitcnt lgkmcnt(" #n ")" ::: "memory")
#define PG8_BAR __builtin_amdgcn_s_barrier()
#define PG8_SCHED __builtin_amdgcn_sched_barrier(0)
    Unit cur, nxt; int ui = 0;
    if (!S.next(0, cur)) return;
    f32x4 acc[2][2][4][2];
#pragma unroll
    for (int a = 0; a < 2; ++a)
#pragma unroll
        for (int b = 0; b < 2; ++b)
#pragma unroll
            for (int m = 0; m < 4; ++m)
#pragma unroll
                for (int n = 0; n < 2; ++n) acc[a][b][m][n] = (f32x4){0.f, 0.f, 0.f, 0.f};
    bf16x8 At[4][2], B0[2][2], B1[2][2];
    const char* cA = (const char*)g.A + (size_t)cur.pm * tstep; const char* cB = (const char*)g.Bt + (size_t)cur.pn * tstep;
    S.a_ready(cur);
    if constexpr (SP2) {
        PG8_STAGE(PG8_SB(0, 0), cB, voffB); PG8_STAGE(PG8_SB(0, 1), cB + hstep, voffB); PG8_STAGE(PG8_SA(0, 0), cA, voffA); PG8_STAGE(PG8_SA(0, 1), cA + hstep, voffA);
        if (wr == 1) PG8_BAR;
        PG8_WAIT_V(2); PG8_BAR;
        PG8_STAGE(PG8_SB(1, 0), cB + kstep, voffB); PG8_STAGE(PG8_SA(1, 0), cA + kstep, voffA); PG8_STAGE(PG8_SB(1, 1), cB + hstep + kstep, voffB);
        PG8_WAIT_V(6); PG8_BAR;
    } else {
        PG8_STAGE(PG8_SB(0, 0), cB, voffB); PG8_STAGE(PG8_SA(0, 0), cA, voffA); PG8_STAGE(PG8_SB(0, 1), cB + hstep, voffB); PG8_STAGE(PG8_SA(0, 1), cA + hstep, voffA);
        if (wr == 1) PG8_BAR;
        PG8_WAIT_V(4); PG8_BAR;
        PG8_STAGE(PG8_SB(1, 0), cB + kstep, voffB); PG8_STAGE(PG8_SA(1, 0), cA + kstep, voffA); PG8_STAGE(PG8_SB(1, 1), cB + hstep + kstep, voffB);
        PG8_WAIT_V(6); PG8_BAR;
    }
    for (;;) {
        const bool has_next = S.next(ui + 1, nxt);
        const char* nA = has_next ? (const char*)g.A + (size_t)nxt.pm * tstep : cA; const char* nB = has_next ? (const char*)g.Bt + (size_t)nxt.pn * tstep : cB;
        for (int t = 0; t < nt; t += 2) {
            const bool last = (t == nt - 2);
            const char* a1 = cA + (size_t)(t + 1) * kstep;
            const char* a2 = last ? nA : cA + (size_t)(t + 2) * kstep; const char* b2 = last ? nB : cB + (size_t)(t + 2) * kstep;
            const char* a3 = a2 + kstep; const char* b3 = b2 + kstep;
            if (last && has_next) S.a_ready(nxt);
            if constexpr (SP2) {
            PG8_LDB(B0, 0, 0); PG8_LDB(B1, 0, 1); PG8_SCHED; PG8_LDA(At, 0, 0); PG8_STAGE(PG8_SA(1, 1), a1 + hstep, voffA);
            PG8_WAIT_V(8); PG8_WAIT_L(0); PG8_BAR; PG8_MMA(0, 0, At, B0); PG8_MMA(0, 1, At, B1); PG8_BAR; PG8_SCHED;
            PG8_LDA(At, 0, 1); PG8_STAGE(PG8_SB(0, 0), b2, voffB); PG8_STAGE(PG8_SB(0, 1), b2 + hstep, voffB); PG8_STAGE(PG8_SA(0, 0), a2, voffA);
            PG8_WAIT_V(8); PG8_WAIT_L(0); PG8_BAR; PG8_MMA(1, 0, At, B0); PG8_MMA(1, 1, At, B1); PG8_BAR; PG8_SCHED;
            PG8_LDB(B0, 1, 0); PG8_LDB(B1, 1, 1); PG8_SCHED; PG8_LDA(At, 1, 0); PG8_STAGE(PG8_SA(0, 1), a2 + hstep, voffA);
            PG8_WAIT_V(8); PG8_WAIT_L(0); PG8_BAR; PG8_MMA(0, 0, At, B0); PG8_MMA(0, 1, At, B1); PG8_BAR; PG8_SCHED;
            PG8_LDA(At, 1, 1); PG8_STAGE(PG8_SB(1, 0), b3, voffB); PG8_STAGE(PG8_SB(1, 1), b3 + hstep, voffB); PG8_STAGE(PG8_SA(1, 0), a3, voffA);
            PG8_WAIT_V(8); PG8_WAIT_L(0); PG8_BAR; PG8_MMA(1, 0, At, B0); PG8_MMA(1, 1, At, B1); PG8_BAR; PG8_SCHED;
            } else {
            PG8_LDB(B0, 0, 0); PG8_SCHED; PG8_LDA(At, 0, 0); PG8_STAGE(PG8_SA(1, 1), a1 + hstep, voffA);
            PG8_WAIT_L(8); PG8_BAR; PG8_WAIT_L(0); PG8_MMA(0, 0, At, B0); PG8_BAR; PG8_SCHED;
            PG8_LDB(B1, 0, 1); PG8_STAGE(PG8_SB(0, 0), b2, voffB);
            PG8_BAR; PG8_WAIT_L(0); PG8_MMA(0, 1, At, B1); PG8_BAR;
            PG8_LDA(At, 0, 1); PG8_STAGE(PG8_SA(0, 0), a2, voffA);
            PG8_BAR; PG8_WAIT_L(0); PG8_MMA(1, 0, At, B0); PG8_BAR; PG8_SCHED;
            PG8_STAGE(PG8_SB(0, 1), b2 + hstep, voffB);
            PG8_WAIT_V(6); PG8_BAR; PG8_MMA(1, 1, At, B1); PG8_BAR;
            PG8_LDB(B0, 1, 0); PG8_SCHED; PG8_LDA(At, 1, 0); PG8_STAGE(PG8_SA(0, 1), a2 + hstep, voffA);
            PG8_WAIT_L(8); PG8_BAR; PG8_WAIT_L(0); PG8_MMA(0, 0, At, B0); PG8_BAR; PG8_SCHED;
            PG8_LDB(B1, 1, 1); PG8_STAGE(PG8_SB(1, 0), b3, voffB);
            PG8_BAR; PG8_WAIT_L(0); PG8_MMA(0, 1, At, B1); PG8_BAR;
            PG8_LDA(At, 1, 1); PG8_STAGE(PG8_SA(1, 0), a3, voffA);
            PG8_BAR; PG8_WAIT_L(0); PG8_MMA(1, 0, At, B0); PG8_BAR; PG8_SCHED;
            PG8_STAGE(PG8_SB(1, 1), b3 + hstep, voffB);
            PG8_WAIT_V(6); PG8_BAR; PG8_MMA(1, 1, At, B1); PG8_BAR;
            }
        }
        if constexpr (ALIGN_EPI) { if (wr == 0) PG8_BAR; }
        if constexpr (!Epi::AFTER_DRAIN) { E(acc, cur, wr, wc, fr, fq); S.done(cur); }
        if (!has_next) break;
#pragma unroll
        for (int a = 0; a < 2; ++a)
#pragma unroll
            for (int b = 0; b < 2; ++b)
#pragma unroll
                for (int m = 0; m < 4; ++m)
#pragma unroll
                    for (int n = 0; n < 2; ++n) acc[a][b][m][n] = (f32x4){0.f, 0.f, 0.f, 0.f};
        cur = nxt; cA = nA; cB = nB; ++ui;
        if constexpr (ALIGN_EPI) { if (wr == 1) PG8_BAR; }
    }
    PG8_WAIT_V(0);
    if constexpr (!ALIGN_EPI) { if (wr == 0) PG8_BAR; }
    PG8_BAR;
    if constexpr (Epi::AFTER_DRAIN) { E.fused(acc, cur, wr, wc, fr, fq, lds, wid, lane); S.done(cur); }
#undef PG8_SA
#undef PG8_SB
#undef PG8_STAGE
#undef PG8_LDA
#undef PG8_LDB
#undef PG8_MMA
#undef PG8_WAIT_V
#undef PG8_WAIT_L
#undef PG8_BAR
#undef PG8_SCHED
}
}
#define GAS __attribute__((address_space(1)))
#define LAS __attribute__((address_space(3)))
typedef unsigned short bf16;
typedef float f32x4 __attribute__((ext_vector_type(4)));
typedef float f32x2 __attribute__((ext_vector_type(2)));
typedef short bf16x8 __attribute__((ext_vector_type(8)));
typedef short s16x4 __attribute__((ext_vector_type(4)));
typedef unsigned u32x4 __attribute__((ext_vector_type(4)));
typedef unsigned u32x2 __attribute__((ext_vector_type(2)));
typedef GAS unsigned gu32;
#define RLX_AGENT __ATOMIC_RELAXED, __HIP_MEMORY_SCOPE_AGENT
#define LDS_WAIT() asm volatile("s_waitcnt lgkmcnt(0)" ::: "memory")
#define MFMA16(a, b, c) __builtin_amdgcn_mfma_f32_16x16x32_bf16((a), (b), (c), 0, 0, 0)
constexpr float LOG2E = 1.4426950408889634f;
__device__ __forceinline__ unsigned pk2(float lo, float hi) { typedef __bf16 b2 __attribute__((ext_vector_type(2))); const f32x2 v = {lo, hi}; const b2 b = __builtin_convertvector(v, b2); return __builtin_bit_cast(unsigned, b); }
__device__ __forceinline__ float bflo(unsigned w) { return __uint_as_float(w << 16); }
__device__ __forceinline__ float bfhi(unsigned w) { return __uint_as_float(w & 0xffff0000u); }
__device__ __forceinline__ float bf2f(bf16 h) { return __uint_as_float((unsigned)h << 16); }
__device__ __forceinline__ u32x4 pk8(const f32x4 a, const f32x4 b) { u32x4 w; w.x = pk2(a[0], a[1]); w.y = pk2(a[2], a[3]); w.z = pk2(b[0], b[1]); w.w = pk2(b[2], b[3]); return w; }
__device__ __forceinline__ bf16x8 asfrag(const u32x4 w) { return __builtin_bit_cast(bf16x8, w); }
__device__ __forceinline__ float ex2(float x) { return __builtin_amdgcn_exp2f(x); }
__device__ __forceinline__ float fexp(float x) { return __builtin_amdgcn_exp2f(x * LOG2E); }
__device__ __forceinline__ float wave_sum(float v) {
#pragma unroll
    for (int o = 1; o < 64; o <<= 1) v += __shfl_xor(v, o);
    return v; }
__device__ __forceinline__ float wave_max(float v) {
#pragma unroll
    for (int o = 1; o < 64; o <<= 1) v = fmaxf(v, __shfl_xor(v, o));
    return v; }
__device__ __forceinline__ float wave_scan_sum(float v, int lane) {
#pragma unroll
    for (int o = 1; o < 64; o <<= 1) { const float t = __shfl_up(v, o); if (lane >= o) v += t; }
    return v; }
__device__ __forceinline__ float wave_scan_max(float v, int lane) {
#pragma unroll
    for (int o = 1; o < 64; o <<= 1) { const float t = __shfl_up(v, o); if (lane >= o) v = fmaxf(v, t); }
    return v; }
__device__ __forceinline__ float xsum4(float v) { v += __shfl_xor(v, 16); v += __shfl_xor(v, 32); return v; }
__device__ __forceinline__ float xmax4(float v) { v = fmaxf(v, __shfl_xor(v, 16)); v = fmaxf(v, __shfl_xor(v, 32)); return v; }
__device__ __forceinline__ bf16x8 tr_frag(const LAS unsigned char* img, int rowbytes, int row0, int col0, int lane) {
    const int g = lane >> 4, l16 = lane & 15, q = l16 >> 2, p = l16 & 3;
    const LAS unsigned char* a = img + (row0 + 8 * g + q) * rowbytes + (col0 + 4 * p) * 2;
    const s16x4 lo = __builtin_amdgcn_ds_read_tr16_b64_v4i16((LAS s16x4*)a);
    const s16x4 hi = __builtin_amdgcn_ds_read_tr16_b64_v4i16((LAS s16x4*)(a + 4 * rowbytes));
    return (bf16x8){lo[0], lo[1], lo[2], lo[3], hi[0], hi[1], hi[2], hi[3]};
}

struct Params {
    const float *x_prompt, *x_sample, *mem_prompt, *cache_k, *cache_v, *cmem_k, *cmem_v, *st_conv, *st_C, *st_n, *st_m, *g_mix, *w_in, *conv_w, *conv_b, *b_gates, *g_mh, *w_out,
                *g_mem, *w_mk, *w_mv, *g_xattn, *w_mq, *w_mo, *g_ffn, *w_gate, *w_up, *w_down, *g_final;
    float* out; unsigned char* ws; int ph_lo, ph_hi, li, pad;
};
typedef const __attribute__((address_space(4))) Params& PRef;
struct Ctx { int tid, lane, wave, vcu, G; LAS unsigned char* W; };

__device__ __forceinline__ void p0_transpose_item(const float* W, const float* gk, int K, int N, int n0s, bf16* WT, int n0d, int k0, LAS float* scr, int lane) {
    float wv[32];
#pragma unroll
    for (int i = 0; i < 32; ++i) wv[i] = W[(size_t)(k0 + 2 * i + (lane >> 5)) * N + n0s + (lane & 31)];
    const float gl = gk ? gk[k0 + lane] : 1.f;
#pragma unroll
    for (int i = 0; i < 32; ++i) { const int kk = 2 * i + (lane >> 5); scr[kk * 33 + (lane & 31)] = __shfl(gl, kk) * wv[i]; }
    LDS_WAIT(); asm volatile("" ::: "memory");
    const int c = lane & 7;
#pragma unroll
    for (int j = 0; j < 4; ++j) { const int n = (lane >> 3) + 8 * j; const LAS float* s = scr + (8 * c) * 33 + n;
        u32x4 o; o.x = pk2(s[0 * 33], s[1 * 33]); o.y = pk2(s[2 * 33], s[3 * 33]); o.z = pk2(s[4 * 33], s[5 * 33]); o.w = pk2(s[6 * 33], s[7 * 33]);
        *(u32x4*)(WT + (size_t)(n0d + n) * K + k0 + 8 * c) = o; }
    LDS_WAIT(); asm volatile("" ::: "memory");
}
__device__ __forceinline__ void ph0_prologue(PRef P, const Ctx& C) {
    unsigned char* ws = P.ws; const int tid = C.tid, lane = C.lane;
    { float* ss = (float*)(ws + WS_SS); for (int i = C.vcu * 512 + tid; i < 3 * MROWS; i += C.G * 512) ss[i] = 0.f; }
    LAS float* wg = (LAS float*)C.W;
    for (int i = tid; i < 1024 * 8; i += 512) { const int k = i >> 3, j = i & 7; wg[j * 1024 + k] = P.g_mix[k] * P.w_in[(size_t)k * NIN + 2048 + j]; }
    __syncthreads();
    bf16* XN = (bf16*)(ws + WS_XN); bf16* MN = (bf16*)(ws + WS_MN); float* GI = (float*)(ws + WS_GI); float* GF = (float*)(ws + WS_GF);
    const int gw = C.vcu * 8 + C.wave, NGW = C.G * 8;
    f32x4 v[4], vn[4];
    { const int m = gw; if (m < MROWS + 512) { const float* xr = m < MP ? P.x_prompt + (size_t)m * DM : (m < MROWS ? P.x_sample + (size_t)(m - MP) * DM : P.mem_prompt + (size_t)(m - MROWS) * DM);
#pragma unroll
        for (int j = 0; j < 4; ++j) v[j] = ((const f32x4*)xr)[lane + 64 * j]; } }
    for (int m = gw; m < MROWS + 512; m += NGW) {
        { const int mn = m + NGW; if (mn < MROWS + 512) { const float* xr = mn < MP ? P.x_prompt + (size_t)mn * DM : (mn < MROWS ? P.x_sample + (size_t)(mn - MP) * DM : P.mem_prompt + (size_t)(mn - MROWS) * DM);
#pragma unroll
            for (int j = 0; j < 4; ++j) vn[j] = ((const f32x4*)xr)[lane + 64 * j]; } }
        float s = 0.f;
#pragma unroll
        for (int j = 0; j < 4; ++j) s += (v[j][0] * v[j][0] + v[j][1] * v[j][1]) + (v[j][2] * v[j][2] + v[j][3] * v[j][3]);
        const float rstd = 1.0f / sqrtf(wave_sum(s) * (1.f / DM) + EPS);
        bf16* orow = m < MROWS ? XN + (size_t)m * DM : MN + (size_t)(m - MROWS) * DM;
#pragma unroll
        for (int j = 0; j < 4; ++j) { v[j] = v[j] * rstd; u32x2 w; w.x = pk2(v[j][0], v[j][1]); w.y = pk2(v[j][2], v[j][3]); ((u32x2*)orow)[lane + 64 * j] = w; }
        if (m < MROWS) {
            float a[8];
#pragma unroll
            for (int jj = 0; jj < 8; ++jj) { float t = 0.f;
#pragma unroll
                for (int j = 0; j < 4; ++j) { const f32x4 w4 = *(const LAS f32x4*)(wg + jj * 1024 + 256 * j + 4 * lane); t += (v[j][0] * w4[0] + v[j][1] * w4[1]) + (v[j][2] * w4[2] + v[j][3] * w4[3]); }
                a[jj] = t; }
            float b4[4], c2[2];
#pragma unroll
            for (int i = 0; i < 4; ++i) { const float keep = (lane & 1) ? a[2 * i + 1] : a[2 * i], give = (lane & 1) ? a[2 * i] : a[2 * i + 1]; b4[i] = keep + __shfl_xor(give, 1); }
#pragma unroll
            for (int i = 0; i < 2; ++i) { const float keep = (lane & 2) ? b4[2 * i + 1] : b4[2 * i], give = (lane & 2) ? b4[2 * i] : b4[2 * i + 1]; c2[i] = keep + __shfl_xor(give, 2); }
            float d1; { const float keep = (lane & 4) ? c2[1] : c2[0], give = (lane & 4) ? c2[0] : c2[1]; d1 = keep + __shfl_xor(give, 4); }
            d1 += __shfl_xor(d1, 8); d1 += __shfl_xor(d1, 16); d1 += __shfl_xor(d1, 32);
            if (lane < 8) { const int jj = lane;
                const float val = d1 + P.b_gates[jj];
                if (jj < 4) GI[(size_t)m * 4 + jj] = val; else GF[(size_t)m * 4 + (jj - 4)] = fminf(val, 0.f) - log1pf(__expf(-fabsf(val))); }
        }
#pragma unroll
        for (int j = 0; j < 4; ++j) v[j] = vn[j];
    }
    __syncthreads();
    LAS float* scr = (LAS float*)(C.W + C.wave * 16384);
    bf16* WIN = (bf16*)(ws + WS_WIN); bf16* WOUT = (bf16*)(ws + WS_WOUT); bf16* WMQ = (bf16*)(ws + WS_WMQ); bf16* WMO = (bf16*)(ws + WS_WMO); bf16* WMKV = (bf16*)(ws + WS_WMKV);
    bf16* WGU = (bf16*)(ws + WS_WGU); bf16* WDN = (bf16*)(ws + WS_WDN);
    constexpr int I_IN = 16 * 112, I_SQ = 16 * 32, I_FF = 16 * 88, I_DN = 44 * 32, NITEMS = I_IN + 5 * I_SQ + 2 * I_FF + I_DN;
    for (int it = gw; it < NITEMS; it += NGW) {
        int r = it;
        if (r < I_IN) { const int kb = r / 112, nd = (r % 112) * 32; p0_transpose_item(P.w_in, P.g_mix, DM, NIN, nd < 2048 ? nd : nd + 8, WIN, nd, kb * 64, scr, lane); continue; } r -= I_IN;
        if (r < I_SQ) { p0_transpose_item(P.w_out, nullptr, DM, DM, (r % 32) * 32, WOUT, (r % 32) * 32, (r / 32) * 64, scr, lane); continue; } r -= I_SQ;
        if (r < I_SQ) { p0_transpose_item(P.w_mk, P.g_mem, DM, DM, (r % 32) * 32, WMKV, (r % 32) * 32, (r / 32) * 64, scr, lane); continue; } r -= I_SQ;
        if (r < I_SQ) { p0_transpose_item(P.w_mv, P.g_mem, DM, DM, (r % 32) * 32, WMKV, 1024 + (r % 32) * 32, (r / 32) * 64, scr, lane); continue; } r -= I_SQ;
        if (r < I_SQ) { p0_transpose_item(P.w_mq, P.g_xattn, DM, DM, (r % 32) * 32, WMQ, (r % 32) * 32, (r / 32) * 64, scr, lane); continue; } r -= I_SQ;
        if (r < I_SQ) { p0_transpose_item(P.w_mo, nullptr, DM, DM, (r % 32) * 32, WMO, (r % 32) * 32, (r / 32) * 64, scr, lane); continue; } r -= I_SQ;
        if (r < I_FF) { const int c0 = (r % 88) * 32; p0_transpose_item(P.w_gate, P.g_ffn, DM, FF, c0, WGU, (c0 >> 7) * 256 + (c0 & 127), (r / 88) * 64, scr, lane); continue; } r -= I_FF;
        if (r < I_FF) { const int c0 = (r % 88) * 32; p0_transpose_item(P.w_up, P.g_ffn, DM, FF, c0, WGU, (c0 >> 7) * 256 + 128 + (c0 & 127), (r / 88) * 64, scr, lane); continue; } r -= I_FF;
        p0_transpose_item(P.w_down, nullptr, FF, DM, (r % 32) * 32, WDN, (r % 32) * 32, (r / 32) * 64, scr, lane);
    }
}

__device__ __forceinline__ void ph2_mlstm_local(PRef P, const Ctx& C) {
    unsigned char* ws = P.ws; const int tid = C.tid, lane = C.lane, wave = C.wave;
    constexpr int RB = 272;
    LAS unsigned char* KW = C.W; LAS unsigned char* VI = C.W + 64 * RB; LAS float* wS = (LAS float*)(C.W + 128 * RB); LAS float* part = wS + 64;
    const bf16* Z = (const bf16*)(ws + WS_Z); const float* GI = (const float*)(ws + WS_GI); const float* GF = (const float*)(ws + WS_GF);
    bf16* QC = (bf16*)(ws + WS_QC); bf16* KC = (bf16*)(ws + WS_KC); float* DCX = (float*)(ws + WS_DCX); float* LSUM = (float*)(ws + WS_LSUM);
    for (int u = C.vcu; u < 8 * NCH; u += C.G) {
        const int bh = u >> 7, c = u & 127, b = bh >> 2, h = bh & 3; const int row0 = b * SEQ + c * 64;
        if (wave == 0) {
            const float ig = GI[(size_t)(row0 + lane) * 4 + h], lf = GF[(size_t)(row0 + lane) * 4 + h];
            const float bs = wave_scan_sum(lf, lane); const float Bc = __shfl(bs, 63); const float gg = Bc - bs + ig; const float Gm = wave_max(gg);
            wS[lane] = fexp(gg - Gm);
            if (lane == 0) { LSUM[(bh * NCH + c) * 2] = Bc; LSUM[(bh * NCH + c) * 2 + 1] = Gm; }
        }
        { const int r = tid >> 3, ch = tid & 7; const bf16* src = Z + (size_t)(row0 + r) * NZ + ZV + h * 128 + ch * 16;
          const u32x4 a = *(const u32x4*)src, bb = *(const u32x4*)(src + 8); *(LAS u32x4*)(VI + r * RB + ch * 32) = a; *(LAS u32x4*)(VI + r * RB + ch * 32 + 16) = bb; }
        __syncthreads();
        { const int cg = tid & 31, tg = tid >> 5; const bool isk = cg >= 16; const int ch = isk ? 512 + h * 128 + (cg - 16) * 8 : h * 128 + cg * 8; const int tl0 = tg * 4;
          float raw[7][8];
#pragma unroll
          for (int jr = 0; jr < 7; ++jr) { const int t = c * 64 + tl0 - 3 + jr; u32x4 w = {0u, 0u, 0u, 0u};
              if (t >= 0) w = *(const u32x4*)(Z + (size_t)(b * SEQ + t) * NZ + ch);
              raw[jr][0] = bflo(w.x); raw[jr][1] = bfhi(w.x); raw[jr][2] = bflo(w.y); raw[jr][3] = bfhi(w.y); raw[jr][4] = bflo(w.z); raw[jr][5] = bfhi(w.z); raw[jr][6] = bflo(w.w); raw[jr][7] = bfhi(w.w); }
          float cw[4][8], cb[8];
#pragma unroll
          for (int j = 0; j < 4; ++j) { const f32x4 a = *(const f32x4*)(P.conv_w + j * 1024 + ch), bq = *(const f32x4*)(P.conv_w + j * 1024 + ch + 4);
              cw[j][0] = a[0]; cw[j][1] = a[1]; cw[j][2] = a[2]; cw[j][3] = a[3]; cw[j][4] = bq[0]; cw[j][5] = bq[1]; cw[j][6] = bq[2]; cw[j][7] = bq[3]; }
          { const f32x4 a = *(const f32x4*)(P.conv_b + ch), bq = *(const f32x4*)(P.conv_b + ch + 4); cb[0] = a[0]; cb[1] = a[1]; cb[2] = a[2]; cb[3] = a[3]; cb[4] = bq[0]; cb[5] = bq[1]; cb[6] = bq[2]; cb[7] = bq[3]; }
#pragma unroll
          for (int tt = 0; tt < 4; ++tt) { float y[8];
#pragma unroll
              for (int i = 0; i < 8; ++i) { float a = cb[i];
#pragma unroll
                  for (int j = 0; j < 4; ++j) a += cw[j][i] * raw[tt + j][i];
                  y[i] = a * __builtin_amdgcn_rcpf(1.f + fexp(-a)); }
              const size_t orow = (size_t)(row0 + tl0 + tt) * 512;
              if (!isk) { u32x4 w; w.x = pk2(y[0], y[1]); w.y = pk2(y[2], y[3]); w.z = pk2(y[4], y[5]); w.w = pk2(y[6], y[7]); *(u32x4*)(QC + orow + h * 128 + cg * 8) = w; }
              else { const float ks = 0.08838834764831845f;
#pragma unroll
                  for (int i = 0; i < 8; ++i) y[i] *= ks;
                  u32x4 w; w.x = pk2(y[0], y[1]); w.y = pk2(y[2], y[3]); w.z = pk2(y[4], y[5]); w.w = pk2(y[6], y[7]); *(u32x4*)(KC + orow + h * 128 + (cg - 16) * 8) = w;
                  const float sw = wS[tl0 + tt];
                  u32x4 w2; w2.x = pk2(y[0] * sw, y[1] * sw); w2.y = pk2(y[2] * sw, y[3] * sw); w2.z = pk2(y[4] * sw, y[5] * sw); w2.w = pk2(y[6] * sw, y[7] * sw);
                  *(LAS u32x4*)(KW + (tl0 + tt) * RB + (cg - 16) * 16) = w2; } }
        }
        __syncthreads();
        { f32x4 acc[8];
#pragma unroll
          for (int et = 0; et < 8; ++et) acc[et] = (f32x4){0.f, 0.f, 0.f, 0.f};
#pragma unroll
          for (int ks = 0; ks < 2; ++ks) { const bf16x8 A = tr_frag(KW, RB, 32 * ks, 16 * wave, lane);
#pragma unroll
              for (int et = 0; et < 8; ++et) { const bf16x8 Bf = tr_frag(VI, RB, 32 * ks, 16 * et, lane); acc[et] = MFMA16(A, Bf, acc[et]); } }
          const int l16 = lane & 15, g = lane >> 4;
#pragma unroll
          for (int et = 0; et < 8; ++et) *(f32x4*)(DCX + ((size_t)(bh * NCH + c) * 129 + 16 * et + l16) * 128 + 16 * wave + 4 * g) = acc[et]; }
        { const int d = tid & 127, sg = tid >> 7; float s = 0.f;
#pragma unroll
          for (int ss = 0; ss < 16; ++ss) s += bf2f(*(const LAS bf16*)(KW + (sg * 16 + ss) * RB + d * 2));
          part[sg * 128 + d] = s; }
        __syncthreads();
        if (tid < 128) DCX[((size_t)(bh * NCH + c) * 129 + 128) * 128 + tid] = (part[tid] + part[128 + tid]) + (part[256 + tid] + part[384 + tid]);
        __syncthreads();
    }
}

__device__ __forceinline__ void ph3_scan_unit(PRef P, const Ctx& C, int u) {
    unsigned char* ws = P.ws; const int tid = C.tid;
    const int bh = u / 33, sl = u - bh * 33; const int idx = sl * 512 + tid;
    LAS float* wcl = (LAS float*)C.W; LAS float* wxl = wcl + 128; LAS float* msl = wxl + 128;
    const float* LS = (const float*)(ws + WS_LSUM) + bh * NCH * 2;
    if (tid == 0) { float m = 0.f;
        for (int c = 0; c < NCH; ++c) { const float Bc = LS[2 * c], Gc = LS[2 * c + 1]; const float mn = fmaxf(m + Bc, Gc); msl[c] = m; wcl[c] = fexp(m + Bc - mn); wxl[c] = fexp(Gc - mn); m = mn; }
        msl[NCH] = m; }
    __syncthreads();
    if (idx < 16512) {
        const float* DCX = (const float*)(ws + WS_DCX) + (size_t)bh * NCH * 16512 + idx;
        bf16* CS = (bf16*)(ws + WS_CS) + (size_t)bh * NCH * 16384 + idx; float* NS = (float*)(ws + WS_NS) + (size_t)bh * NCH * 128 + (idx - 16384);
        const bool isc = idx < 16384;
        float st = 0.f; float x[16], xn[16];
#pragma unroll
        for (int j = 0; j < 16; ++j) x[j] = DCX[(size_t)j * 16512];
#pragma unroll 1
        for (int c0 = 0; c0 < NCH; c0 += 16) {
            if (c0 + 16 < NCH) {
#pragma unroll
                for (int j = 0; j < 16; ++j) xn[j] = DCX[(size_t)(c0 + 16 + j) * 16512]; }
#pragma unroll
            for (int j = 0; j < 16; ++j) { const int c = c0 + j;
                if (isc) CS[(size_t)c * 16384] = (bf16)(pk2(st, 0.f) & 0xffffu); else NS[(size_t)c * 128] = st;
                st = wcl[c] * st + wxl[c] * x[j]; }
#pragma unroll
            for (int j = 0; j < 16; ++j) x[j] = xn[j];
        }
        if (isc) { const int e = idx >> 7, d = idx & 127; P.out[O_PC + ((size_t)bh * 128 + d) * 128 + e] = st; }
        else P.out[O_PN + bh * 128 + (idx - 16384)] = st;
        if (idx < 128) ((float*)(ws + WS_MST))[bh * NCH + idx] = msl[idx];
        if (idx == 0) P.out[O_PM + bh] = msl[NCH];
    }
    __syncthreads();
}

constexpr float ATT_SCL = 0.125f * LOG2E;
__device__ __forceinline__ void softmax_pv(float (&s)[8], float& m_run, float& l_run, f32x4 (&O)[4], const LAS unsigned char* Vst, int lane) {
    float mx = fmaxf(fmaxf(fmaxf(s[0], s[1]), fmaxf(s[2], s[3])), fmaxf(fmaxf(s[4], s[5]), fmaxf(s[6], s[7])));
    mx = xmax4(mx);
    const float mn = fmaxf(m_run, mx); const float alpha = ex2(m_run - mn); m_run = mn;
    float ps = 0.f;
#pragma unroll
    for (int i = 0; i < 8; ++i) { s[i] = ex2(s[i] - mn); ps += s[i]; }
    l_run = l_run * alpha + ps;
#pragma unroll
    for (int dt = 0; dt < 4; ++dt) O[dt] = O[dt] * alpha;
    u32x4 pw; pw.x = pk2(s[0], s[1]); pw.y = pk2(s[2], s[3]); pw.z = pk2(s[4], s[5]); pw.w = pk2(s[6], s[7]);
    const bf16x8 pf = asfrag(pw);
#pragma unroll
    for (int dt = 0; dt < 4; ++dt) { const bf16x8 vf = tr_frag(Vst, 144, 0, 16 * dt, lane); O[dt] = MFMA16(vf, pf, O[dt]); }
}
struct KV8 { u32x4 k[4]; u32x4 v[4]; };
__device__ __forceinline__ void pattn_load(KV8& r, const bf16* Kh, const bf16* Vh, int tokbase, int kb, int sh, int lane) {
    const int l16 = lane & 15, g = lane >> 4;
#pragma unroll
    for (int hf = 0; hf < 2; ++hf) { const int kap = kb + 8 * (l16 >> 2) + 4 * hf + (l16 & 3); int kt = tokbase + kap * (1 << sh); kt = kt < 0 ? 0 : kt;
        const bf16* p = Kh + (size_t)kt * NZ + 8 * g; r.k[2 * hf] = *(const u32x4*)p; r.k[2 * hf + 1] = *(const u32x4*)(p + 32); }
#pragma unroll
    for (int it = 0; it < 4; ++it) { const int rho = it * 8 + (lane >> 3), ch = lane & 7; int kt = tokbase + (kb + rho) * (1 << sh); kt = kt < 0 ? 0 : kt;
        r.v[it] = *(const u32x4*)(Vh + (size_t)kt * NZ + ch * 8); }
}
__device__ __forceinline__ void ph3_attn_prompt_unit(PRef P, const Ctx& C, int u) {
    unsigned char* ws = P.ws; const int lane = C.lane, wave = C.wave;
    const int b = u >> 8, h = (u >> 5) & 7, blk = u & 31; const int T0 = blk * 256;
    const bf16* Zr = (const bf16*)(ws + WS_Z) + (size_t)b * SEQ * NZ + h * 64;
    const bf16* Qh = Zr + ZQA; const bf16* Kh = Zr + ZKA; const bf16* Vh = Zr + ZVA; bf16* MIX = (bf16*)(ws + WS_MIX);
    LAS float* Ost = (LAS float*)C.W; LAS float* Mst = (LAS float*)(C.W + 69632); LAS float* Lst = Mst + 256; LAS unsigned char* Vst = C.W + 71680 + wave * 4608;
    const int g = lane >> 4, l16 = lane & 15;
    for (int br = 0; br < 3; ++br) {
        const int sh = 2 * br;
        for (int j = 0; j < 2; ++j) {
            const int st = 2 * wave + j;
            const int base = (br == 0) ? 16 * st : (br == 1) ? 64 * (st >> 2) + (st & 3) : st;
            const int tokl = base + (l16 << sh);
            KV8 cur, nxt; pattn_load(cur, Kh, Vh, T0 + base, -144, sh, lane);
            const bf16* qp = Qh + (size_t)(T0 + tokl) * NZ + 8 * g;
            const bf16x8 q0 = *(const bf16x8*)qp, q1 = *(const bf16x8*)(qp + 32);
            float m_run, l_run; f32x4 O[4];
            if (br == 0) { m_run = -1e30f; l_run = 0.f;
#pragma unroll
                for (int dt = 0; dt < 4; ++dt) O[dt] = (f32x4){0.f, 0.f, 0.f, 0.f}; }
            else { m_run = Mst[tokl]; l_run = (g == 0) ? Lst[tokl] : 0.f;
#pragma unroll
                for (int dt = 0; dt < 4; ++dt) O[dt] = *(const LAS f32x4*)(Ost + tokl * 68 + 16 * dt + 4 * g); }
#pragma unroll 1
            for (int ks = 0; ks < 5; ++ks) {
                const int kb = -144 + 32 * ks;
                if (ks < 4) pattn_load(nxt, Kh, Vh, T0 + base, kb + 32, sh, lane);
#pragma unroll
                for (int it = 0; it < 4; ++it) *(LAS u32x4*)(Vst + (it * 8 + (lane >> 3)) * 144 + (lane & 7) * 16) = cur.v[it];
                f32x4 S[2];
#pragma unroll
                for (int hf = 0; hf < 2; ++hf) { S[hf] = MFMA16(asfrag(cur.k[2 * hf]), q0, ((f32x4){0.f, 0.f, 0.f, 0.f})); S[hf] = MFMA16(asfrag(cur.k[2 * hf + 1]), q1, S[hf]); }
                float s[8];
#pragma unroll
                for (int hf = 0; hf < 2; ++hf)
#pragma unroll
                    for (int ii = 0; ii < 4; ++ii) { const int kap = kb + 8 * g + 4 * hf + ii; const int dist = l16 - kap; const int ktok = T0 + base + (kap << sh);
                        const bool ok = (dist >= 0) && (dist <= 128) && (ktok >= 0); s[hf * 4 + ii] = ok ? S[hf][ii] * ATT_SCL : -INFINITY; }
                softmax_pv(s, m_run, l_run, O, Vst, lane);
                if (ks < 4) cur = nxt;
            }
            const float lt = xsum4(l_run);
            if (br < 2) {
#pragma unroll
                for (int dt = 0; dt < 4; ++dt) *(LAS f32x4*)(Ost + tokl * 68 + 16 * dt + 4 * g) = O[dt];
                if (g == 0) { Mst[tokl] = m_run; Lst[tokl] = lt; }
            } else { const float inv = 1.f / lt; bf16* op = MIX + ((size_t)b * SEQ + T0 + tokl) * DM + 512 + h * 64 + 4 * g;
#pragma unroll
                for (int dt = 0; dt < 4; ++dt) { u32x2 w; w.x = pk2(O[dt][0] * inv, O[dt][1] * inv); w.y = pk2(O[dt][2] * inv, O[dt][3] * inv); *(u32x2*)(op + 16 * dt) = w; } }
        }
        __syncthreads();
    }
}

__device__ __forceinline__ int samp_pos(int v) { return v < 384 ? 16 * (v >> 2) + (v & 3) : 1152 + v; }
struct KV16 { f32x4 k[8]; f32x4 v[4][2]; };
__device__ __forceinline__ void bfx(const u32x4 w, f32x4& a, f32x4& b) { a = (f32x4){bflo(w.x), bfhi(w.x), bflo(w.y), bfhi(w.y)}; b = (f32x4){bflo(w.z), bfhi(w.z), bflo(w.w), bfhi(w.w)}; }
__device__ __forceinline__ void sattn_load(KV16& r, const float* ck, const float* cv, const bf16* Zk, const bf16* Zv, int ks, int lane) {
    const int l16 = lane & 15, g = lane >> 4;
#pragma unroll
    for (int hf = 0; hf < 2; ++hf) { const int v = 32 * ks + 8 * (l16 >> 2) + 4 * hf + (l16 & 3);
        if (v < 896) { const float* kp = ck + (size_t)samp_pos(v) * 512 + 8 * g; r.k[4 * hf] = *(const f32x4*)kp; r.k[4 * hf + 1] = *(const f32x4*)(kp + 4); r.k[4 * hf + 2] = *(const f32x4*)(kp + 32); r.k[4 * hf + 3] = *(const f32x4*)(kp + 36); }
        else if (v < 900) { const bf16* kp = Zk + (size_t)(v - 896) * NZ + 8 * g; bfx(*(const u32x4*)kp, r.k[4 * hf], r.k[4 * hf + 1]); bfx(*(const u32x4*)(kp + 32), r.k[4 * hf + 2], r.k[4 * hf + 3]); }
        else { r.k[4 * hf] = r.k[4 * hf + 1] = r.k[4 * hf + 2] = r.k[4 * hf + 3] = (f32x4){0.f, 0.f, 0.f, 0.f}; } }
#pragma unroll
    for (int it = 0; it < 4; ++it) { const int rho = it * 8 + (lane >> 3), ch = lane & 7; const int v = 32 * ks + rho;
        if (v < 896) { const float* vp = cv + (size_t)samp_pos(v) * 512 + ch * 8; r.v[it][0] = *(const f32x4*)vp; r.v[it][1] = *(const f32x4*)(vp + 4); }
        else if (v < 900) bfx(*(const u32x4*)(Zv + (size_t)(v - 896) * NZ + ch * 8), r.v[it][0], r.v[it][1]);
        else { r.v[it][0] = r.v[it][1] = (f32x4){0.f, 0.f, 0.f, 0.f}; } }
}
__device__ __forceinline__ void sattn_step(const KV16& r, int ks, const bf16x8 q0, const bf16x8 q1, float& m_run, float& l_run, f32x4 (&O)[4], LAS unsigned char* Vst, int lane) {
    const int l16 = lane & 15, g = lane >> 4;
#pragma unroll
    for (int it = 0; it < 4; ++it) *(LAS u32x4*)(Vst + (it * 8 + (lane >> 3)) * 144 + (lane & 7) * 16) = pk8(r.v[it][0], r.v[it][1]);
    f32x4 S[2];
#pragma unroll
    for (int hf = 0; hf < 2; ++hf) { S[hf] = MFMA16(asfrag(pk8(r.k[4 * hf], r.k[4 * hf + 1])), q0, ((f32x4){0.f, 0.f, 0.f, 0.f})); S[hf] = MFMA16(asfrag(pk8(r.k[4 * hf + 2], r.k[4 * hf + 3])), q1, S[hf]); }
    float s[8];
#pragma unroll
    for (int hf = 0; hf < 2; ++hf)
#pragma unroll
        for (int ii = 0; ii < 4; ++ii) { const int v = 32 * ks + 8 * g + 4 * hf + ii; const int t = l16; int cnt = 0;
            if (t < 4) { if (v < 896) { const int p = samp_pos(v); cnt = (p >= 1920 + t ? 1 : 0) + ((p >= 1536 && (p & 3) == t) ? 1 : 0) + ((p & 15) == t ? 1 : 0); }
                         else if (v < 900) { const int tp = v - 896; cnt = (tp <= t ? 1 : 0) + (tp == t ? 2 : 0); } }
            const float lg = cnt == 3 ? 1.5849625007211562f : (cnt == 2 ? 1.f : 0.f);
            s[hf * 4 + ii] = cnt > 0 ? S[hf][ii] * ATT_SCL + lg : -INFINITY; }
    softmax_pv(s, m_run, l_run, O, Vst, lane);
}
__device__ __forceinline__ void ph3_attn_sample_unit(PRef P, const Ctx& C, int db) {
    unsigned char* ws = P.ws; const int lane = C.lane, h = C.wave; const int g = lane >> 4, l16 = lane & 15; const int tq = l16 < 3 ? l16 : 3;
    const bf16* Z = (const bf16*)(ws + WS_Z); bf16* MIX = (bf16*)(ws + WS_MIX);
    const size_t srow = (size_t)MP + db * 4;
    LAS unsigned char* Vst = C.W + C.wave * 4608;
    const float* ck = P.cache_k + (size_t)db * WB * 512 + h * 64; const float* cv = P.cache_v + (size_t)db * WB * 512 + h * 64;
    const bf16* Zk = Z + srow * NZ + ZKA + h * 64; const bf16* Zv = Z + srow * NZ + ZVA + h * 64;
    KV16 A, B; sattn_load(A, ck, cv, Zk, Zv, 0, lane);
    const bf16* qp = Z + (srow + tq) * NZ + ZQA + h * 64 + 8 * g;
    const bf16x8 q0 = *(const bf16x8*)qp, q1 = *(const bf16x8*)(qp + 32);
    float m_run = -1e30f, l_run = 0.f; f32x4 O[4];
#pragma unroll
    for (int dt = 0; dt < 4; ++dt) O[dt] = (f32x4){0.f, 0.f, 0.f, 0.f};
#pragma unroll 1
    for (int ks = 0; ks < 28; ks += 2) {
        sattn_load(B, ck, cv, Zk, Zv, ks + 1, lane); sattn_step(A, ks, q0, q1, m_run, l_run, O, Vst, lane);
        sattn_load(A, ck, cv, Zk, Zv, ks + 2, lane); sattn_step(B, ks + 1, q0, q1, m_run, l_run, O, Vst, lane);
    }
    sattn_step(A, 28, q0, q1, m_run, l_run, O, Vst, lane);
    const float lt = xsum4(l_run);
    if (l16 < 4) { const float inv = 1.f / lt; bf16* op = MIX + (srow + l16) * DM + 512 + h * 64 + 4 * g;
#pragma unroll
        for (int dt = 0; dt < 4; ++dt) { u32x2 w; w.x = pk2(O[dt][0] * inv, O[dt][1] * inv); w.y = pk2(O[dt][2] * inv, O[dt][3] * inv); *(u32x2*)(op + 16 * dt) = w; } }
}

__device__ __forceinline__ void ph3_mlstm_sample_unit(PRef P, const Ctx& C, int u) {
    unsigned char* ws = P.ws; const int tid = C.tid, lane = C.lane, wave = C.wave;
    const int db = u >> 2, h = u & 3; const size_t srow = (size_t)MP + db * 4;
    const bf16* Z = (const bf16*)(ws + WS_Z); bf16* MIX = (bf16*)(ws + WS_MIX); const float* GI = (const float*)(ws + WS_GI); const float* GF = (const float*)(ws + WS_GF);
    LAS float* qk = (LAS float*)C.W;
    LAS float* vv = qk + 1024;
    LAS float* pn = vv + 512;
    LAS float* pd = pn + 512;
    LAS float* hb = pd + 16;
    if (tid < 256) { const int ch = tid < 128 ? h * 128 + tid : 512 + h * 128 + (tid - 128);
        float up[7];
#pragma unroll
        for (int j = 0; j < 3; ++j) up[j] = P.st_conv[((size_t)db * 3 + j) * 1024 + ch];
#pragma unroll
        for (int t = 0; t < 4; ++t) up[3 + t] = bf2f(Z[(srow + t) * NZ + ch]);
        const float cb = P.conv_b[ch]; float cw[4];
#pragma unroll
        for (int j = 0; j < 4; ++j) cw[j] = P.conv_w[j * 1024 + ch];
#pragma unroll
        for (int t = 0; t < 4; ++t) { float a = cb;
#pragma unroll
            for (int j = 0; j < 4; ++j) a += cw[j] * up[t + j];
            a = a * __builtin_amdgcn_rcpf(1.f + fexp(-a)); if (tid >= 128) a *= 0.08838834764831845f; qk[t * 256 + tid] = a; } }
    else if (tid < 384) { const int e = tid - 256;
#pragma unroll
        for (int t = 0; t < 4; ++t) vv[t * 128 + e] = bf2f(Z[(srow + t) * NZ + ZV + h * 128 + e]); }
    const int e = tid & 127, dq = tid >> 7;
    float Cr[32], nr[32];
    { const float* cp = P.st_C + ((size_t)(db * 4 + h) * 128 + dq * 32) * 128 + e; const float* np = P.st_n + (size_t)(db * 4 + h) * 128 + dq * 32;
#pragma unroll
      for (int r = 0; r < 32; ++r) { Cr[r] = cp[(size_t)r * 128]; nr[r] = np[r]; } }
    float m = P.st_m[db * 4 + h];
    __syncthreads();
#pragma unroll 1
    for (int t = 0; t < 4; ++t) {
        const float ig = GI[(srow + t) * 4 + h], lf = GF[(srow + t) * 4 + h];
        const float mn = fmaxf(lf + m, ig); const float fw = fexp(lf + m - mn), iw = fexp(ig - mn); m = mn;
        const float ve = vv[t * 128 + e]; float num = 0.f, den = 0.f;
#pragma unroll
        for (int r = 0; r < 32; ++r) { const float kd = qk[t * 256 + 128 + dq * 32 + r], qd = qk[t * 256 + dq * 32 + r];
            Cr[r] = fw * Cr[r] + iw * kd * ve; nr[r] = fw * nr[r] + iw * kd; num += qd * Cr[r]; den += qd * nr[r]; }
        pn[dq * 128 + e] = num; if (e == 0) pd[dq] = den;
        __syncthreads();
        if (tid < 128) { const float nm = (pn[tid] + pn[128 + tid]) + (pn[256 + tid] + pn[384 + tid]); const float dn = (pd[0] + pd[1]) + (pd[2] + pd[3]);
            hb[tid] = nm / fmaxf(fabsf(dn), fexp(-m)); }
        __syncthreads();
        if (wave == 0) { const float h0 = hb[lane], h1 = hb[64 + lane]; const float mean = wave_sum(h0 + h1) * (1.f / 128.f); const float d0 = h0 - mean, d1 = h1 - mean;
            const float var = wave_sum(d0 * d0 + d1 * d1) * (1.f / 128.f); const float rstd = 1.0f / sqrtf(var + EPS);
            const float o0 = bf2f(Z[(srow + t) * NZ + ZO + h * 128 + lane]), o1 = bf2f(Z[(srow + t) * NZ + ZO + h * 128 + 64 + lane]);
            const float y0 = d0 * rstd * P.g_mh[h * 128 + lane] * __builtin_amdgcn_rcpf(1.f + fexp(-o0)), y1 = d1 * rstd * P.g_mh[h * 128 + 64 + lane] * __builtin_amdgcn_rcpf(1.f + fexp(-o1));
            MIX[(srow + t) * DM + h * 128 + lane] = (bf16)(pk2(y0, 0.f) & 0xffffu); MIX[(srow + t) * DM + h * 128 + 64 + lane] = (bf16)(pk2(y1, 0.f) & 0xffffu); }
        __syncthreads();
    }
    { float* co = P.out + O_SC + ((size_t)(db * 4 + h) * 128 + dq * 32) * 128 + e;
#pragma unroll
      for (int r = 0; r < 32; ++r) co[(size_t)r * 128] = Cr[r];
      if (e == 0) { float* no = P.out + O_SN + (size_t)(db * 4 + h) * 128 + dq * 32;
#pragma unroll
          for (int r = 0; r < 32; ++r) no[r] = nr[r]; }
      if (tid == 0) P.out[O_SM + db * 4 + h] = m; }
    __syncthreads();
}

__device__ __forceinline__ void ph4_mlstm_out(PRef P, const Ctx& C) {
    unsigned char* ws = P.ws; const int tid = C.tid, lane = C.lane, wave = C.wave; const int g = lane >> 4, l16 = lane & 15;
    constexpr int RB = 272;
    const bf16* Z = (const bf16*)(ws + WS_Z); const float* GI = (const float*)(ws + WS_GI); const float* GF = (const float*)(ws + WS_GF);
    const bf16* QC = (const bf16*)(ws + WS_QC); const bf16* KC = (const bf16*)(ws + WS_KC); const bf16* CS = (const bf16*)(ws + WS_CS); const float* NS = (const float*)(ws + WS_NS);
    const float* MST = (const float*)(ws + WS_MST); bf16* MIX = (bf16*)(ws + WS_MIX);
    LAS unsigned char* VI = C.W + (wave >> 2) * 64 * RB;
    LAS float* sc = (LAS float*)(C.W + 2 * 64 * RB) + wave * 256;
    for (int u = C.vcu; u < 8 * (NCH / 2); u += C.G) {
        const int bh = u >> 6, cp = u & 63, b = bh >> 2, h = bh & 3;
        { const int ci = tid >> 8, r = (tid & 255) >> 2, qd = tid & 3; const bf16* src = Z + (size_t)(b * SEQ + (2 * cp + ci) * 64 + r) * NZ + ZV + h * 128 + qd * 32;
          LAS unsigned char* dst = C.W + ci * 64 * RB + r * RB + qd * 64;
#pragma unroll
          for (int i = 0; i < 4; ++i) *(LAS u32x4*)(dst + 16 * i) = *(const u32x4*)(src + 8 * i); }
        const int c = 2 * cp + (wave >> 2), T = wave & 3; const int row0 = b * SEQ + c * 64;
        { const float ig = GI[(size_t)(row0 + lane) * 4 + h], lf = GF[(size_t)(row0 + lane) * 4 + h];
          const float bs = wave_scan_sum(lf, lane); const float us = ig - bs; const float pm = wave_scan_max(us, lane); const float ms = MST[bh * NCH + c];
          const float mt = bs + fmaxf(ms, pm);
          sc[lane] = bs - mt; sc[64 + lane] = fexp(bs + ms - mt); sc[128 + lane] = fexp(-mt); sc[192 + lane] = us; }
        __syncthreads();
        const int t = 16 * T + l16;
        const float bm_t = sc[t], wa_t = sc[64 + t], em_t = sc[128 + t];
        bf16x8 qf[4];
        { const bf16* qp = QC + (size_t)(row0 + t) * 512 + h * 128 + 8 * g;
#pragma unroll
          for (int kk = 0; kk < 4; ++kk) qf[kk] = *(const bf16x8*)(qp + 32 * kk); }
        f32x4 acc[8];
        { const bf16* cb = CS + (size_t)(bh * NCH + c) * 16384 + (size_t)l16 * 128 + 8 * g;
#pragma unroll
          for (int et = 0; et < 8; ++et) { acc[et] = (f32x4){0.f, 0.f, 0.f, 0.f};
#pragma unroll
              for (int kk = 0; kk < 4; ++kk) { const bf16x8 cf = *(const bf16x8*)(cb + (size_t)et * 16 * 128 + 32 * kk); acc[et] = MFMA16(cf, qf[kk], acc[et]); }
              acc[et] = acc[et] * wa_t; } }
        float den;
        { const float* np = NS + (size_t)(bh * NCH + c) * 128 + 8 * g; float qn = 0.f;
#pragma unroll
          for (int kk = 0; kk < 4; ++kk) { const f32x4 n0 = *(const f32x4*)(np + 32 * kk), n1 = *(const f32x4*)(np + 32 * kk + 4); const u32x4 qw = __builtin_bit_cast(u32x4, qf[kk]);
              qn += (bflo(qw.x) * n0[0] + bfhi(qw.x) * n0[1]) + (bflo(qw.y) * n0[2] + bfhi(qw.y) * n0[3]) + (bflo(qw.z) * n1[0] + bfhi(qw.z) * n1[1]) + (bflo(qw.w) * n1[2] + bfhi(qw.w) * n1[3]); }
          den = wa_t * xsum4(qn); }
        float rsum = 0.f;
        for (int p = 0; p <= (T >> 1); ++p) {
            float w[8];
#pragma unroll
            for (int hf = 0; hf < 2; ++hf) { const int s_a = 32 * p + 8 * (l16 >> 2) + 4 * hf + (l16 & 3);
                const bf16* kp = KC + (size_t)(row0 + s_a) * 512 + h * 128 + 8 * g; f32x4 S = {0.f, 0.f, 0.f, 0.f};
#pragma unroll
                for (int kk = 0; kk < 4; ++kk) S = MFMA16(*(const bf16x8*)(kp + 32 * kk), qf[kk], S);
                const f32x4 us4 = *(const LAS f32x4*)(sc + 192 + 32 * p + 8 * g + 4 * hf);
#pragma unroll
                for (int ii = 0; ii < 4; ++ii) { const int s_d = 32 * p + 8 * g + 4 * hf + ii; const float wv = (s_d <= t) ? S[ii] * fexp(bm_t + us4[ii]) : 0.f; w[hf * 4 + ii] = wv; rsum += wv; } }
            u32x4 pw; pw.x = pk2(w[0], w[1]); pw.y = pk2(w[2], w[3]); pw.z = pk2(w[4], w[5]); pw.w = pk2(w[6], w[7]);
            const bf16x8 pf = asfrag(pw);
#pragma unroll
            for (int et = 0; et < 8; ++et) { const bf16x8 vf = tr_frag(VI, RB, 32 * p, 16 * et, lane); acc[et] = MFMA16(vf, pf, acc[et]); }
        }
        den += xsum4(rsum);
        const float inv = 1.f / fmaxf(fabsf(den), em_t);
        float sm = 0.f;
#pragma unroll
        for (int et = 0; et < 8; ++et) { acc[et] = acc[et] * inv; sm += (acc[et][0] + acc[et][1]) + (acc[et][2] + acc[et][3]); }
        const float mean = xsum4(sm) * (1.f / 128.f); float sq = 0.f;
#pragma unroll
        for (int et = 0; et < 8; ++et) { acc[et] = acc[et] - mean; sq += (acc[et][0] * acc[et][0] + acc[et][1] * acc[et][1]) + (acc[et][2] * acc[et][2] + acc[et][3] * acc[et][3]); }
        const float rstd = 1.0f / sqrtf(xsum4(sq) * (1.f / 128.f) + EPS);
        { const bf16* op = Z + (size_t)(row0 + t) * NZ + ZO + h * 128 + 4 * g; bf16* mp = MIX + (size_t)(row0 + t) * DM + h * 128 + 4 * g; const float* gp = P.g_mh + h * 128 + 4 * g;
#pragma unroll
          for (int et = 0; et < 8; ++et) { const u32x2 ow = *(const u32x2*)(op + 16 * et); const f32x4 gm = *(const f32x4*)(gp + 16 * et);
              const float y0 = acc[et][0] * rstd * gm[0] * __builtin_amdgcn_rcpf(1.f + fexp(-bflo(ow.x))), y1 = acc[et][1] * rstd * gm[1] * __builtin_amdgcn_rcpf(1.f + fexp(-bfhi(ow.x)));
              const float y2 = acc[et][2] * rstd * gm[2] * __builtin_amdgcn_rcpf(1.f + fexp(-bflo(ow.y))), y3 = acc[et][3] * rstd * gm[3] * __builtin_amdgcn_rcpf(1.f + fexp(-bfhi(ow.y)));
              u32x2 w2; w2.x = pk2(y0, y1); w2.y = pk2(y2, y3); *(u32x2*)(mp + 16 * et) = w2; } }
        __syncthreads();
    }
}

__device__ __forceinline__ void ph7_xattn_prompt_unit(PRef P, const Ctx& C, int u) {
    unsigned char* ws = P.ws; const int tid = C.tid, lane = C.lane, wave = C.wave; const int g = lane >> 4, l16 = lane & 15;
    constexpr int RB = 528;
    const int b = u >> 8, h = (u >> 6) & 3, qb = u & 63;
    const bf16* QX = (const bf16*)(ws + WS_QX); const bf16* MK = (const bf16*)(ws + WS_MEMK); const bf16* MV = (const bf16*)(ws + WS_MEMV); bf16* OX = (bf16*)(ws + WS_OX);
    LAS unsigned char* KI = C.W; LAS unsigned char* VI = C.W + 32 * RB;
    const int r0 = tid >> 5, c0 = tid & 31;
    const bf16* ksrc = MK + (size_t)(b * 256 + r0) * 1024 + h * 256 + c0 * 8; const bf16* vsrc = MV + (size_t)(b * 256 + r0) * 1024 + h * 256 + c0 * 8;
    LAS unsigned char* kdst = KI + r0 * RB + c0 * 16; LAS unsigned char* vdst = VI + r0 * RB + c0 * 16;
    u32x4 kr0 = *(const u32x4*)ksrc, kr1 = *(const u32x4*)(ksrc + 16 * 1024), vr0 = *(const u32x4*)vsrc, vr1 = *(const u32x4*)(vsrc + 16 * 1024);
    const size_t qrow = (size_t)b * SEQ + qb * 128 + wave * 16 + l16;
    bf16x8 qf[8];
    { const bf16* qp = QX + qrow * DM + h * 256 + 8 * g;
#pragma unroll
      for (int kk = 0; kk < 8; ++kk) qf[kk] = *(const bf16x8*)(qp + 32 * kk); }
    f32x4 O[16]; float m_run = -1e30f, l_run = 0.f;
#pragma unroll
    for (int dt = 0; dt < 16; ++dt) O[dt] = (f32x4){0.f, 0.f, 0.f, 0.f};
    *(LAS u32x4*)kdst = kr0; *(LAS u32x4*)(kdst + 16 * RB) = kr1; *(LAS u32x4*)vdst = vr0; *(LAS u32x4*)(vdst + 16 * RB) = vr1;
    __syncthreads();
    const LAS unsigned char* kfb = KI + (8 * (l16 >> 2) + (l16 & 3)) * RB + 16 * g;
#pragma unroll 1
    for (int ks = 0; ks < 8; ++ks) {
        if (ks < 7) { const size_t o = (size_t)(32 * (ks + 1)) * 1024; kr0 = *(const u32x4*)(ksrc + o); kr1 = *(const u32x4*)(ksrc + o + 16 * 1024); vr0 = *(const u32x4*)(vsrc + o); vr1 = *(const u32x4*)(vsrc + o + 16 * 1024); }
        f32x4 S0 = {0.f, 0.f, 0.f, 0.f}, S1 = {0.f, 0.f, 0.f, 0.f};
#pragma unroll
        for (int kk = 0; kk < 8; ++kk) { const bf16x8 k0 = *(const LAS bf16x8*)(kfb + 64 * kk), k1 = *(const LAS bf16x8*)(kfb + 4 * RB + 64 * kk);
            S0 = MFMA16(k0, qf[kk], S0); S1 = MFMA16(k1, qf[kk], S1); }
        float mx = fmaxf(fmaxf(fmaxf(S0[0], S0[1]), fmaxf(S0[2], S0[3])), fmaxf(fmaxf(S1[0], S1[1]), fmaxf(S1[2], S1[3])));
        mx = xmax4(mx); const float mn = fmaxf(m_run, mx); const float alpha = ex2(m_run - mn); m_run = mn;
        float s[8]; float ps = 0.f;
#pragma unroll
        for (int i = 0; i < 4; ++i) { s[i] = ex2(S0[i] - mn); s[4 + i] = ex2(S1[i] - mn); ps += s[i] + s[4 + i]; }
        l_run = l_run * alpha + ps;
#pragma unroll
        for (int dt = 0; dt < 16; ++dt) O[dt] = O[dt] * alpha;
        u32x4 pw; pw.x = pk2(s[0], s[1]); pw.y = pk2(s[2], s[3]); pw.z = pk2(s[4], s[5]); pw.w = pk2(s[6], s[7]); const bf16x8 pf = asfrag(pw);
#pragma unroll
        for (int dt = 0; dt < 16; ++dt) { const bf16x8 vf = tr_frag(VI, RB, 0, 16 * dt, lane); O[dt] = MFMA16(vf, pf, O[dt]); }
        __syncthreads();
        if (ks < 7) { *(LAS u32x4*)kdst = kr0; *(LAS u32x4*)(kdst + 16 * RB) = kr1; *(LAS u32x4*)vdst = vr0; *(LAS u32x4*)(vdst + 16 * RB) = vr1; }
        __syncthreads();
    }
    { const float inv = 1.f / xsum4(l_run); bf16* op = OX + qrow * DM + h * 256 + 4 * g;
#pragma unroll
      for (int dt = 0; dt < 16; ++dt) { u32x2 w; w.x = pk2(O[dt][0] * inv, O[dt][1] * inv); w.y = pk2(O[dt][2] * inv, O[dt][3] * inv); *(u32x2*)(op + 16 * dt) = w; } }
}
__device__ __forceinline__ void ph7_xattn_sample_unit(PRef P, const Ctx& C, int u) {
    unsigned char* ws = P.ws; const int tid = C.tid, lane = C.lane, wave = C.wave; const int g = lane >> 4, l16 = lane & 15; const int tq = l16 < 3 ? l16 : 3;
    const int db = u >> 1, hp = u & 1; const int head = hp * 2 + (wave >> 2), kq = wave & 3; const size_t srow = (size_t)MP + db * 4;
    const bf16* QX = (const bf16*)(ws + WS_QX); bf16* OX = (bf16*)(ws + WS_OX);
    LAS float* Pl = (LAS float*)C.W + wave * 256;
    LAS float* Mg = (LAS float*)(C.W + 8192);
    LAS float* Lg = Mg + 32;
    LAS float* Og = (LAS float*)(C.W + 8192 + 256);
    bf16x8 qf[8];
    { const bf16* qp = QX + (srow + tq) * DM + head * 256 + 8 * g;
#pragma unroll
      for (int kk = 0; kk < 8; ++kk) qf[kk] = *(const bf16x8*)(qp + 32 * kk); }
    const float* kb = P.cmem_k + ((size_t)(db * 256 + kq * 64) * 4 + head) * 256; const float* vb = P.cmem_v + ((size_t)(db * 256 + kq * 64) * 4 + head) * 256;
    f32x4 S[2][2];
#pragma unroll
    for (int ks = 0; ks < 2; ++ks)
#pragma unroll
        for (int hf = 0; hf < 2; ++hf) { const int key = 32 * ks + 8 * (l16 >> 2) + 4 * hf + (l16 & 3); const float* kp = kb + (size_t)key * 1024 + 8 * g; f32x4 a = {0.f, 0.f, 0.f, 0.f};
#pragma unroll
            for (int kk = 0; kk < 8; ++kk) { const u32x4 kw = pk8(*(const f32x4*)(kp + 32 * kk), *(const f32x4*)(kp + 32 * kk + 4)); a = MFMA16(asfrag(kw), qf[kk], a); }
            S[ks][hf] = a; }
    float mx = -INFINITY;
#pragma unroll
    for (int ks = 0; ks < 2; ++ks)
#pragma unroll
        for (int hf = 0; hf < 2; ++hf)
#pragma unroll
            for (int ii = 0; ii < 4; ++ii) mx = fmaxf(mx, S[ks][hf][ii]);
    mx = xmax4(mx); float ps = 0.f;
#pragma unroll
    for (int ks = 0; ks < 2; ++ks)
#pragma unroll
        for (int hf = 0; hf < 2; ++hf)
#pragma unroll
            for (int ii = 0; ii < 4; ++ii) { const float pv = ex2(S[ks][hf][ii] - mx); ps += pv; if (l16 < 4) Pl[(32 * ks + 8 * g + 4 * hf + ii) * 4 + l16] = pv; }
    ps = xsum4(ps);
    if (lane < 4) { Mg[wave * 4 + lane] = mx; Lg[wave * 4 + lane] = ps; }
    LDS_WAIT(); asm volatile("" ::: "memory");
    f32x4 o0 = {0.f, 0.f, 0.f, 0.f}, o1 = o0, o2 = o0, o3 = o0;
#pragma unroll 8
    for (int key = 0; key < 64; ++key) { const f32x4 v4 = *(const f32x4*)(vb + (size_t)key * 1024 + 4 * lane); const f32x4 p4 = *(const LAS f32x4*)(Pl + key * 4);
        o0 += v4 * p4[0]; o1 += v4 * p4[1]; o2 += v4 * p4[2]; o3 += v4 * p4[3]; }
    { LAS float* og = Og + wave * 1024 + 4 * lane; *(LAS f32x4*)og = o0; *(LAS f32x4*)(og + 256) = o1; *(LAS f32x4*)(og + 512) = o2; *(LAS f32x4*)(og + 768) = o3; }
    __syncthreads();
    { const int hd = tid >> 8, t = (tid >> 6) & 3, d4 = (tid & 63) * 4; const int w0 = hd * 4;
      const float m0 = Mg[(w0 + 0) * 4 + t], m1 = Mg[(w0 + 1) * 4 + t], m2 = Mg[(w0 + 2) * 4 + t], m3 = Mg[(w0 + 3) * 4 + t]; const float mm = fmaxf(fmaxf(m0, m1), fmaxf(m2, m3));
      const float f0 = ex2(m0 - mm), f1 = ex2(m1 - mm), f2 = ex2(m2 - mm), f3 = ex2(m3 - mm);
      const float lt = (f0 * Lg[(w0 + 0) * 4 + t] + f1 * Lg[(w0 + 1) * 4 + t]) + (f2 * Lg[(w0 + 2) * 4 + t] + f3 * Lg[(w0 + 3) * 4 + t]);
      const f32x4 a0 = *(const LAS f32x4*)(Og + (w0 + 0) * 1024 + t * 256 + d4), a1 = *(const LAS f32x4*)(Og + (w0 + 1) * 1024 + t * 256 + d4), a2 = *(const LAS f32x4*)(Og + (w0 + 2) * 1024 + t * 256 + d4), a3 = *(const LAS f32x4*)(Og + (w0 + 3) * 1024 + t * 256 + d4);
      const f32x4 o = ((a0 * f0 + a1 * f1) + (a2 * f2 + a3 * f3)) * (1.f / lt);
      u32x2 w; w.x = pk2(o[0], o[1]); w.y = pk2(o[2], o[3]); *(u32x2*)(OX + (srow + t) * DM + (hp * 2 + hd) * 256 + d4) = w; }
    __syncthreads();
}

template <class F> __device__ __forceinline__ void skinny_gemm(const Ctx& C, const bf16* A, const bf16* Bt, int K, int N, const F& f) {
    const int lane = C.lane, g = lane >> 4, l16 = lane & 15; const int ntask = 32 * (N >> 4);
    for (int wt = C.vcu * 8 + C.wave; wt < ntask; wt += C.G * 8) {
        const int mt = wt & 31, nt = wt >> 5;
        const bf16* ap = A + (size_t)(16 * mt + l16) * K + 8 * g; const bf16* bp = Bt + (size_t)(16 * nt + l16) * K + 8 * g;
        f32x4 acc = {0.f, 0.f, 0.f, 0.f};
#pragma unroll 1
        for (int k0 = 0; k0 < K; k0 += 256) { bf16x8 a[8], b[8];
#pragma unroll
            for (int j = 0; j < 8; ++j) { a[j] = *(const bf16x8*)(ap + k0 + 32 * j); b[j] = *(const bf16x8*)(bp + k0 + 32 * j); }
#pragma unroll
            for (int j = 0; j < 8; ++j) acc = MFMA16(b[j], a[j], acc); }
        f(16 * mt + l16, 16 * nt + 4 * g, acc);
    }
}
struct SkRes {
    const float* base; float* X; bf16* Xb; float* SS;
    __device__ __forceinline__ void operator()(int row, int col, const f32x4 a) const { const size_t off = (size_t)row * DM + col; const f32x4 v = *(const f32x4*)(base + off) + a; *(f32x4*)(X + off) = v;
        if (Xb) { u32x2 w; w.x = pk2(v[0], v[1]); w.y = pk2(v[2], v[3]); *(u32x2*)(Xb + off) = w; }
        const float ssq = xsum4((v[0] * v[0] + v[1] * v[1]) + (v[2] * v[2] + v[3] * v[3])); if ((threadIdx.x & 48) == 0) unsafeAtomicAdd(SS + row, ssq); }
};
struct SkQ {
    bf16* Q; const float* SS; float scale;
    __device__ __forceinline__ void operator()(int row, int col, const f32x4 a) const { const float rs = __builtin_amdgcn_rsqf(SS[row] * (1.f / DM) + EPS) * scale;
        u32x2 w; w.x = pk2(a[0] * rs, a[1] * rs); w.y = pk2(a[2] * rs, a[3] * rs); *(u32x2*)(Q + (size_t)row * DM + col) = w; }
};

__device__ __forceinline__ void ph11_final(PRef P, const Ctx& C) {
    const float* X3 = (const float*)(P.ws + WS_X3); const float* SS3 = (const float*)(P.ws + WS_SS) + 2 * MROWS; const int lane = C.lane;
    const int gw = C.vcu * 8 + C.wave, NGW = C.G * 8;
    f32x4 gv[4];
#pragma unroll
    for (int j = 0; j < 4; ++j) gv[j] = ((const f32x4*)P.g_final)[lane + 64 * j];
    for (int m = gw; m < MROWS; m += NGW) { const float rs = 1.0f / sqrtf(SS3[m] * (1.f / DM) + EPS); const f32x4* xr = (const f32x4*)(X3 + (size_t)m * DM); f32x4* yr = (f32x4*)(P.out + O_Y + (size_t)m * DM);
#pragma unroll
        for (int j = 0; j < 4; ++j) yr[lane + 64 * j] = xr[lane + 64 * j] * rs * gv[j]; }
}
#define XB_TMO      128
#define XB_XCNT(j)  (256  + 64 * (j))
#define XB_XSUB(j)  (1280 + 64 * (j))
#define XB_XGEN(j)  (2304 + 64 * (j))
#define XB_TOP      3328
#define XB_TOPGEN   3392
#define XCD_BAR_WORDS 3456
#define XB_SPIN_CAP (1u << 18)

__device__ __forceinline__ unsigned xb_ld(unsigned* p)              { return __hip_atomic_load(p, __ATOMIC_RELAXED, __HIP_MEMORY_SCOPE_AGENT); }
__device__ __forceinline__ unsigned xb_add(unsigned* p, unsigned v) { return __hip_atomic_fetch_add(p, v, __ATOMIC_RELAXED, __HIP_MEMORY_SCOPE_AGENT); }
__device__ __forceinline__ unsigned xb_xcc_id() { return (unsigned)__builtin_amdgcn_s_getreg((3 << 11) | 20) & 0xFu; }
#define XB_SPIN(cond, bar) do { unsigned _sp = 0; while (cond) { __builtin_amdgcn_s_sleep(1); \
    if ((++_sp & 255u) == 0u) { if (xb_ld(&(bar)[XB_TMO])) break; if (_sp > XB_SPIN_CAP) { atomicAdd(&(bar)[XB_TMO], 1u); break; } } } } while (0)

struct XcdBarrier {
    unsigned* bar; unsigned x;
    volatile LAS unsigned* st;
};

__device__ __forceinline__ XcdBarrier xcd_barrier_post(unsigned* bar, volatile LAS unsigned* st) {
    XcdBarrier b; b.bar = bar; b.x = xb_xcc_id(); b.st = st;
    if (threadIdx.x == 0) (void)xb_add(&bar[XB_XCNT(b.x)], 1u);
    return b;
}
__device__ __forceinline__ void xcd_barrier_complete(unsigned* bar, unsigned x, unsigned& nloc, unsigned& nx) {
    const unsigned G = gridDim.x * gridDim.y * gridDim.z;
    unsigned sum, cnt, mine, sp = 0u;
    for (;;) {
        sum = 0u; cnt = 0u; mine = 0u;
#pragma unroll
        for (unsigned j = 0; j < 16; ++j) { const unsigned c = xb_ld(&bar[XB_XCNT(j)]); sum += c; cnt += (c > 0u) ? 1u : 0u; mine = (j == x) ? c : mine; }
        if (sum == G) break;
        __builtin_amdgcn_s_sleep(1);
        if ((++sp & 255u) == 0u) { if (xb_ld(&bar[XB_TMO])) break; if (sp > XB_SPIN_CAP) { atomicAdd(&bar[XB_TMO], 1u); break; } }
    }
    nloc = mine > 0u ? mine : 1u; nx = cnt > 0u ? cnt : 1u;
}

__device__ __forceinline__ void xcd_barrier(const XcdBarrier& b) {
    asm volatile("s_waitcnt vmcnt(0)" ::: "memory");
    __syncthreads();
    if (threadIdx.x == 0) {
        unsigned* bar = b.bar;
        __builtin_amdgcn_s_waitcnt(0);
        unsigned nloc = b.st[0], nx = b.st[1];
        if (nloc == 0u) { xcd_barrier_complete(bar, b.x, nloc, nx); b.st[0] = nloc; b.st[1] = nx; }
        const unsigned old = xb_add(&bar[XB_XSUB(b.x)], 1u);
        const unsigned gen = old / nloc;
        if (old + 1u == (gen + 1u) * nloc) {
            __builtin_amdgcn_fence(__ATOMIC_RELEASE, "agent");
            asm volatile("s_waitcnt vmcnt(0)" ::: "memory");
            const unsigned og = xb_add(&bar[XB_TOP], 1u);
            const unsigned tg = og / nx;
            if (og + 1u == (tg + 1u) * nx) xb_add(&bar[XB_TOPGEN], 1u);
            else XB_SPIN(xb_ld(&bar[XB_TOPGEN]) == tg, bar);
            __builtin_amdgcn_fence(__ATOMIC_ACQUIRE, "agent");
            xb_add(&bar[XB_XGEN(b.x)], 1u);
            asm volatile("s_waitcnt vmcnt(0)" ::: "memory");
        } else {
            XB_SPIN(xb_ld(&bar[XB_XGEN(b.x)]) == gen, bar);
            __builtin_amdgcn_fence(__ATOMIC_ACQUIRE, "agent");
            asm volatile("s_waitcnt vmcnt(0)" ::: "memory");
        }
    }
    __syncthreads();
}
constexpr int NPH = 12;
constexpr int CW_Q3 = 8192;
#ifndef PROBE_PHASE
#define PROBE_PHASE -1
#endif
#ifndef PROBE_EXTRA
#define PROBE_EXTRA 1
#endif
#ifndef ONLY_SUB
#define ONLY_SUB -1
#endif
#define SUB(k) if (ONLY_SUB < 0 || ONLY_SUB == (k))
#define REP(k) for (int rp_ = 0; rp_ < ((PROBE_PHASE == (k)) ? 1 + PROBE_EXTRA : 1); ++rp_)
constexpr int N_LAUNCHES = MK_N_LAUNCHES;
constexpr int LDS_BYTES = 147456, LDS_WORK_OFF = 1024;
__global__ void __launch_bounds__(512, 2) hymba_fwd(Params Pval) {
    const __attribute__((address_space(4))) Params* kp_ = (const __attribute__((address_space(4))) Params*)__builtin_amdgcn_kernarg_segment_ptr();
#define P (*({ const __attribute__((address_space(4))) Params* q_ = kp_; asm volatile("" : "+s"(q_)); q_; }))
    extern __shared__ __attribute__((aligned(16))) unsigned char lds_raw[];
    LAS unsigned char* lds = (LAS unsigned char*)lds_raw;
    Ctx C; C.tid = threadIdx.x; C.lane = C.tid & 63; C.wave = __builtin_amdgcn_readfirstlane(C.tid >> 6);
    C.G = gridDim.x; { const int bx = blockIdx.x; C.vcu = (C.G % 8 == 0) ? (bx % 8) * (C.G / 8) + bx / 8 : bx; }
    C.W = lds + LDS_WORK_OFF;
    for (int i = C.tid; i < LDS_WORK_OFF / 4; i += 512) ((LAS unsigned*)lds)[i] = 0u;
    __syncthreads();
    unsigned char* ws = P.ws;
    unsigned* barw = (unsigned*)(ws + WS_CTL) + CW_BAR;
    XcdBarrier bar; bar.bar = barw; bar.x = 0; bar.st = nullptr;
    if (N_LAUNCHES == 1) bar = xcd_barrier_post(barw, (volatile LAS unsigned*)(lds + 64));
    const int lo = P.ph_lo, hi = P.ph_hi;
#ifndef ONLY_PHASE
#define ONLY_PHASE -1
#endif
#define IN(k) ((ONLY_PHASE < 0 || ONLY_PHASE == (k)) && lo <= (k) && (k) < hi)
#define SEAM(k) do { if (IN(k) && IN((k) + 1)) xcd_barrier(bar); } while (0)
    bf16* XN = (bf16*)(ws + WS_XN); bf16* Zb = (bf16*)(ws + WS_Z); bf16* MIX = (bf16*)(ws + WS_MIX);
    float* SS1 = (float*)(ws + WS_SS); float* SS2 = SS1 + MROWS; float* SS3 = SS2 + MROWS; float* SSD = SS3 + MROWS; float* SS1_ = SS1; float* SS2_ = SS2; float* SS3_ = SS3;
    float* X1 = (float*)(ws + WS_X1); bf16* X1B = (bf16*)(ws + WS_X1B); float* X2 = (float*)(ws + WS_X2); bf16* X2B = (bf16*)(ws + WS_X2B); float* X3 = (float*)(ws + WS_X3);

    if (IN(0)) { REP(0) { ph0_prologue(P, C); __syncthreads(); } } SEAM(0);
    if (IN(1)) REP(1) {
        { pg8::Gemm g{XN, (const bf16*)(ws + WS_WIN), MROWS, NZ, DM}; pg8::StaticOrder S; S.init(MROWS, NZ, C.G, (int)blockIdx.x); pg8::EpiIn E{Zb, P.out};
          pg8::gemm_phase<pg8::EpiIn, pg8::StaticOrder, true, true>(C.W, g, S, E); }
        { pg8::Gemm g{(const bf16*)(ws + WS_MN), (const bf16*)(ws + WS_WMKV), 512, 2048, DM}; pg8::StaticOrder S; S.init(512, 2048, C.G, C.G - 1 - (int)blockIdx.x);
          pg8::EpiMem E{(bf16*)(ws + WS_MEMK), (bf16*)(ws + WS_MEMV), P.out};
          pg8::gemm_phase<pg8::EpiMem, pg8::StaticOrder, true, true>(C.W, g, S, E); }
    } SEAM(1);
    if (IN(2)) { REP(2) ph2_mlstm_local(P, C); } SEAM(2);
    if (IN(3)) {
        constexpr int Q_SA = DBATCH, Q_PA = Q_SA + 512, Q_SC = Q_PA + 264, Q_SM = Q_SC + 512;
        gu32* qctr = (gu32*)(ws + WS_CTL) + CW_Q3; volatile LAS int* qslot = (volatile LAS int*)(lds + 128);
        int it = C.vcu;
        for (;;) {
            if (it >= Q_SM) break;
            if (it < Q_SA) { SUB(33) ph3_attn_sample_unit(P, C, it); }
            else if (it < Q_PA) { SUB(31) ph3_attn_prompt_unit(P, C, it - Q_SA); }
            else if (it < Q_SC) { SUB(30) ph3_scan_unit(P, C, it - Q_PA); }
            else { SUB(32) ph3_mlstm_sample_unit(P, C, it - Q_SC); }
            __syncthreads();
            if (C.tid == 0) *qslot = C.G + (int)__hip_atomic_fetch_add(qctr, 1u, RLX_AGENT);
            __syncthreads();
            it = __builtin_amdgcn_readfirstlane(*qslot);
        }
    } SEAM(3);
    if (IN(4)) { REP(4) ph4_mlstm_out(P, C); } SEAM(4);
    if (IN(5)) REP(5) { float* SS1 = rp_ ? SSD : SS1_; { pg8::Gemm g{MIX, (const bf16*)(ws + WS_WOUT), MP, DM, DM}; pg8::StaticOrder S; S.init(MP, DM, C.G, (int)blockIdx.x); pg8::EpiRes E{P.x_prompt, P.x_sample, X1, X1B, SS1};
        pg8::gemm_phase<pg8::EpiRes, pg8::StaticOrder, true, true>(C.W, g, S, E); }
        skinny_gemm(C, MIX + (size_t)MP * DM, (const bf16*)(ws + WS_WOUT), DM, DM, SkRes{P.x_sample, X1 + (size_t)MP * DM, X1B + (size_t)MP * DM, SS1 + MP}); } SEAM(5);
    if (IN(6)) REP(6) { { pg8::Gemm g{X1B, (const bf16*)(ws + WS_WMQ), MP, DM, DM}; pg8::StaticOrder S; S.init(MP, DM, C.G, (int)blockIdx.x); pg8::EpiQ E{(bf16*)(ws + WS_QX), SS1, 0.0625f * LOG2E};
        pg8::gemm_phase<pg8::EpiQ, pg8::StaticOrder, true, true>(C.W, g, S, E); }
        skinny_gemm(C, X1B + (size_t)MP * DM, (const bf16*)(ws + WS_WMQ), DM, DM, SkQ{(bf16*)(ws + WS_QX) + (size_t)MP * DM, SS1 + MP, 0.0625f * LOG2E}); } SEAM(6);
    if (IN(7)) {
        SUB(70) REP(70) for (int u = C.vcu; u < 512; u += C.G) ph7_xattn_prompt_unit(P, C, u);
        SUB(71) REP(71) for (int u = C.vcu; u < 256; u += C.G) ph7_xattn_sample_unit(P, C, u);
    } SEAM(7);
    if (IN(8)) REP(8) { float* SS2 = rp_ ? SSD : SS2_; { pg8::Gemm g{(const bf16*)(ws + WS_OX), (const bf16*)(ws + WS_WMO), MP, DM, DM}; pg8::StaticOrder S; S.init(MP, DM, C.G, (int)blockIdx.x); pg8::EpiRes E{X1, X1 + (size_t)MP * DM, X2, X2B, SS2};
        pg8::gemm_phase<pg8::EpiRes, pg8::StaticOrder, true, true>(C.W, g, S, E); }
        skinny_gemm(C, (const bf16*)(ws + WS_OX) + (size_t)MP * DM, (const bf16*)(ws + WS_WMO), DM, DM, SkRes{X1 + (size_t)MP * DM, X2 + (size_t)MP * DM, X2B + (size_t)MP * DM, SS2 + MP}); } SEAM(8);
    if (IN(9)) REP(9) { pg8::Gemm g{X2B, (const bf16*)(ws + WS_WGU), MROWS, NGU, DM}; pg8::StaticOrder S; S.init(MROWS, NGU, C.G, (int)blockIdx.x); pg8::EpiGU E{(bf16*)(ws + WS_H), SS2};
        pg8::gemm_phase<pg8::EpiGU, pg8::StaticOrder, true, true>(C.W, g, S, E); } SEAM(9);
    if (IN(10)) REP(10) { float* SS3 = rp_ ? SSD : SS3_; { pg8::Gemm g{(const bf16*)(ws + WS_H), (const bf16*)(ws + WS_WDN), MP, DM, FF}; pg8::StaticOrder S; S.init(MP, DM, C.G, (int)blockIdx.x); pg8::EpiRes E{X2, X2 + (size_t)MP * DM, X3, nullptr, SS3};
        pg8::gemm_phase<pg8::EpiRes, pg8::StaticOrder, true, true>(C.W, g, S, E); }
        skinny_gemm(C, (const bf16*)(ws + WS_H) + (size_t)MP * FF, (const bf16*)(ws + WS_WDN), FF, DM, SkRes{X2 + (size_t)MP * DM, X3 + (size_t)MP * DM, nullptr, SS3 + MP}); } SEAM(10);
    if (IN(11)) { REP(11) ph11_final(P, C); }
#undef IN
#undef SEAM
#undef P
}

extern "C" void kernel_launch(void* const* d_in, const int* in_sizes, int n_in, void* d_out, int out_size, void* d_ws, size_t ws_size, hipStream_t stream) {
    static int grid = 0;
    if (grid == 0) {
        if (n_in != 29 || (size_t)out_size != O_END || ws_size < WS_END) { fprintf(stderr, "kernel_launch: unexpected shapes: n_in %d out %d (want %zu) ws %zu (want >= %zu)\n", n_in, out_size, (size_t)O_END, ws_size, (size_t)WS_END); grid = -1; return; }
        int dev = 0, cus = 0, per_cu = 0;
        if (hipGetDevice(&dev) != hipSuccess || hipDeviceGetAttribute(&cus, hipDeviceAttributeMultiprocessorCount, dev) != hipSuccess) { grid = -1; return; }
        if (hipFuncSetAttribute((const void*)hymba_fwd, hipFuncAttributeMaxDynamicSharedMemorySize, LDS_BYTES) != hipSuccess) { fprintf(stderr, "kernel_launch: hipFuncSetAttribute failed\n"); grid = -1; return; }
        if (hipOccupancyMaxActiveBlocksPerMultiprocessor(&per_cu, (const void*)hymba_fwd, 512, LDS_BYTES) != hipSuccess || per_cu < 1) fprintf(stderr, "kernel_launch: occupancy query says %d\n", per_cu);
        (void)hipGetLastError();
        grid = cus;
    }
    if (grid < 0) return;
    (void)hipMemsetAsync((char*)d_ws + WS_CTL, 0, CTL_ZERO_BYTES, stream);
    Params p{};
    const float** pp = (const float**)&p;
    for (int i = 0; i < 29; ++i) pp[i] = (const float*)d_in[i];
    p.out = (float*)d_out; p.ws = (unsigned char*)d_ws; p.pad = 0;
    if (N_LAUNCHES == 1) { p.ph_lo = 0; p.ph_hi = NPH; p.li = 0; hipLaunchKernelGGL(hymba_fwd, dim3(grid), dim3(512), LDS_BYTES, stream, p); }
    else { for (int k = 0; k < NPH; ++k) { p.ph_lo = k; p.ph_hi = k + 1; p.li = k; hipLaunchKernelGGL(hymba_fwd, dim3(grid), dim3(512), LDS_BYTES, stream, p); } }
    const hipError_t le = hipPeekAtLastError();
    if (le != hipSuccess) fprintf(stderr, "kernel_launch: launch failed: %s\n", hipGetErrorName(le));
}
```
